# Optimizing an MI355X kernel written in HIP

```python
import jax, jax.numpy as jnp
from jax import lax
import numpy as np

D_MODEL = 2048
BATCH = 16
SEQ = 256
DEPTH = 2
DEC_BATCH = 4
DEC_SEQ = 1024
PAST_LEN = 512

GRID_W = 64
HEAD_DIM = 128
ATT_HEADS = 8
ATT_KV_HEADS = 2
ATT_GROUPS = ATT_HEADS // ATT_KV_HEADS
ATT_W = ATT_HEADS * HEAD_DIM
ATT_KV_W = ATT_KV_HEADS * HEAD_DIM
ML_HEADS = 4
ML_DK = 128
ML_DV = 128
ML_W = ML_HEADS * ML_DV
FO_GROUPS = 4
FO_GC = 128
FO_W = FO_GROUPS * FO_GC
D_MIX = ATT_W + ML_W + FO_W
N_GATES = 4 * ML_HEADS
PROJ_SIZES = (ATT_W, ATT_KV_W, ATT_KV_W, ATT_W, ML_W, ML_W, ML_W, ML_W, ML_W, N_GATES, FO_W, FO_W)
D_PROJ = 2 * ATT_W + 2 * ATT_KV_W + 5 * ML_W + N_GATES + 2 * FO_W
CONV_W = 3
CHUNK = 64
Q_BLOCK = 128
ROPE_BASE = 10000.0
EPS = 1e-6

kernel_name = 'hybrid_attn_mlstm_fourier_diffusion_step'


def rms_norm(x, w):
    xf = x.astype(jnp.float32)
    y = xf * lax.rsqrt(jnp.mean(xf * xf, axis=-1, keepdims=True) + EPS)
    return (y * w.astype(jnp.float32)).astype(x.dtype)


def rope_2d(x, n_rows):
    half = x.shape[-1] // 2
    inv_freq = ROPE_BASE ** (-jnp.arange(0, half, 2, dtype=jnp.float32) / half)
    rows = jnp.repeat(jnp.arange(n_rows, dtype=jnp.float32), GRID_W)
    cols = jnp.tile(jnp.arange(GRID_W, dtype=jnp.float32), n_rows)
    xf = x.astype(jnp.float32)

    def rot(xh, pos):
        ang = pos[:, None] * inv_freq
        cos = jnp.cos(ang)[:, None, :]
        sin = jnp.sin(ang)[:, None, :]
        x1, x2 = jnp.split(xh, 2, axis=-1)
        return jnp.concatenate([x1 * cos - x2 * sin, x1 * sin + x2 * cos], axis=-1)

    out = jnp.concatenate([rot(xf[..., :half], rows), rot(xf[..., half:], cols)], axis=-1)
    return out.astype(x.dtype)


def short_conv(x, w, b):
    T = x.shape[1]
    pad = CONV_W // 2
    xp = jnp.pad(x, ((0, 0), (pad, pad), (0, 0)))
    return sum(xp[:, j:j + T] * w[j] for j in range(CONV_W)) + b


def mlstm_chunkwise(q, k, v, ig, lf, C0, n0, m0):
    B, H, T, _ = q.shape
    DV = v.shape[-1]
    nc = T // CHUNK
    to_chunks = lambda a: jnp.moveaxis(a.reshape(B, H, nc, CHUNK, *a.shape[3:]), 2, 0)
    causal = jnp.tril(jnp.ones((CHUNK, CHUNK), dtype=bool))

    def step(carry, inp):
        C, n, m = carry
        qc, kc, vc, ic, fc = inp
        b = jnp.cumsum(fc, axis=-1)
        dmat = jnp.where(causal, b[..., :, None] - b[..., None, :] + ic[..., None, :], -jnp.inf)
        inter = b + m[..., None]
        m_row = jnp.maximum(inter, jnp.max(dmat, axis=-1))
        s = jnp.einsum('bhld,bhsd->bhls', qc, kc) * jnp.exp(dmat - m_row[..., None])
        w_inter = jnp.exp(inter - m_row)
        num = w_inter[..., None] * jnp.einsum('bhld,bhde->bhle', qc, C) + jnp.einsum('bhls,bhse->bhle', s, vc)
        den = w_inter * jnp.einsum('bhld,bhd->bhl', qc, n) + jnp.sum(s, axis=-1)
        h = num / jnp.maximum(jnp.abs(den), jnp.exp(-m_row))[..., None]
        b_last = b[..., -1]
        g = b_last[..., None] - b + ic
        m_new = jnp.maximum(b_last + m, jnp.max(g, axis=-1))
        w_k = jnp.exp(g - m_new[..., None])
        decay = jnp.exp(b_last + m - m_new)
        C_new = decay[..., None, None] * C + jnp.einsum('bhs,bhsd,bhse->bhde', w_k, kc, vc)
        n_new = decay[..., None] * n + jnp.einsum('bhs,bhsd->bhd', w_k, kc)
        return (C_new, n_new, m_new), h

    init = (C0.astype(jnp.float32), n0.astype(jnp.float32), m0.astype(jnp.float32))
    (C, n, m), hs = lax.scan(step, init, (to_chunks(q), to_chunks(k), to_chunks(v), to_chunks(ig), to_chunks(lf)))
    h = jnp.moveaxis(hs, 0, 2).reshape(B, H, T, DV)
    return h, (C, n, m)


def mlstm_bidir(q, k, v, gates, C0, n0, m0):
    B, T = gates.shape[:2]
    g = gates.reshape(B, T, 4, ML_HEADS).transpose(2, 0, 3, 1)
    ig_f, lf_f = g[0], jax.nn.log_sigmoid(g[1])
    ig_b, lf_b = g[2], jax.nn.log_sigmoid(g[3])
    h_f, (Cf, nf, mf) = mlstm_chunkwise(q, k, v, ig_f, lf_f, C0[:, 0], n0[:, 0], m0[:, 0])
    h_b, (Cb, nb, mb) = mlstm_chunkwise(jnp.flip(q, 2), jnp.flip(k, 2), jnp.flip(v, 2),
                                        jnp.flip(ig_b, -1), jnp.flip(lf_b, -1), C0[:, 1], n0[:, 1], m0[:, 1])
    h = h_f + jnp.flip(h_b, 2)
    return h, (jnp.stack([Cf, Cb], axis=1), jnp.stack([nf, nb], axis=1), jnp.stack([mf, mb], axis=1))


def block_attention(q, k, v):
    B, T, KVH, G, HD = q.shape
    nb = T // Q_BLOCK
    qb = jnp.swapaxes(q.reshape(B, nb, Q_BLOCK, KVH, G, HD), 0, 1)

    def one_block(qi):
        s = jnp.einsum('bqhgd,bkhd->bhgqk', qi, k).astype(jnp.float32) * (HD ** -0.5)
        p = jax.nn.softmax(s, axis=-1).astype(v.dtype)
        return jnp.einsum('bhgqk,bkhd->bqhgd', p, v)

    o = lax.map(one_block, qb)
    return jnp.swapaxes(o, 0, 1).reshape(B, T, KVH * G * HD)


def mixer_layer(x, cond, lw, ctx_kv, ml_state, n_rows):
    (norm_w, w_mod, b_mod, w_in, b_if, conv_w, conv_b, q_norm, k_norm, ml_norm, w_fno, w_out) = lw
    B, T, _ = x.shape
    mod = jax.nn.silu(cond) @ w_mod + b_mod
    shift, scale, gate = jnp.split(mod[:, None, :], 3, axis=-1)
    h = rms_norm(x, norm_w) * (1 + scale) + shift
    z = h @ w_in
    (aq, ak, av, ag, mq, mk, mv, mo, mg, mif, fx, fg) = jnp.split(z, np.cumsum(PROJ_SIZES)[:-1].tolist(), axis=-1)

    q = rms_norm(aq.reshape(B, T, ATT_HEADS, HEAD_DIM), q_norm)
    k = rms_norm(ak.reshape(B, T, ATT_KV_HEADS, HEAD_DIM), k_norm)
    v = av.reshape(B, T, ATT_KV_HEADS, HEAD_DIM)
    if ctx_kv is None:
        k_all, v_all = k, v
    else:
        q = rope_2d(q, n_rows)
        k = rope_2d(k, n_rows)
        k_all = jnp.concatenate([ctx_kv[0].astype(k.dtype), k], axis=1)
        v_all = jnp.concatenate([ctx_kv[1].astype(v.dtype), v], axis=1)
    o_att = block_attention(q.reshape(B, T, ATT_KV_HEADS, ATT_GROUPS, HEAD_DIM), k_all, v_all) * jax.nn.silu(ag)

    qk = jax.nn.silu(short_conv(jnp.concatenate([mq, mk], axis=-1), conv_w, conv_b))
    mq_c, mk_c = jnp.split(qk, 2, axis=-1)
    heads = lambda a: a.reshape(B, T, ML_HEADS, -1).transpose(0, 2, 1, 3).astype(jnp.float32)
    gates = mif.astype(jnp.float32) + b_if.astype(jnp.float32)
    hm, (C_f, n_f, m_f) = mlstm_bidir(heads(mq_c), heads(mk_c) * (ML_DK ** -0.5), heads(mv), gates,
                                      ml_state[0], ml_state[1], ml_state[2])
    hm = rms_norm(hm.transpose(0, 2, 1, 3), ml_norm.reshape(ML_HEADS, ML_DV)).astype(x.dtype)
    o_ml = hm.reshape(B, T, ML_W) * jax.nn.sigmoid(mo) * jax.nn.silu(mg)

    f = jnp.fft.fftn(fx.reshape(B, T, FO_GROUPS, FO_GC).astype(jnp.float32), axes=(1, 3), norm='ortho').real
    o_fo = jnp.einsum('btgc,gcd->btgd', f.astype(x.dtype), w_fno).reshape(B, T, FO_W) * jax.nn.silu(fg)

    y = jnp.concatenate([o_att, o_ml, o_fo], axis=-1) @ w_out
    return x + gate * y, (k, v, C_f, n_f, m_f)


def setup_inputs(seed: int = 0) -> dict:
    key = jax.random.key(seed)
    ks = jax.random.split(key, 21)
    nrm = lambda i, shape, s: s * jax.random.normal(ks[i], shape, jnp.float32)
    f_off = jnp.tile(jnp.repeat(jnp.array([0.0, 3.0], jnp.float32), ML_HEADS), 2)
    return {
        'x_prompt': nrm(0, (BATCH, SEQ, D_MODEL), 1.0),
        'x_sample': nrm(1, (DEC_BATCH, DEC_SEQ, D_MODEL), 1.0),
        'cache_k': nrm(2, (DEC_BATCH, DEPTH, PAST_LEN, ATT_KV_HEADS, HEAD_DIM), 1.0),
        'cache_v': nrm(3, (DEC_BATCH, DEPTH, PAST_LEN, ATT_KV_HEADS, HEAD_DIM), 1.0),
        'state_C': nrm(4, (DEC_BATCH, DEPTH, 2, ML_HEADS, ML_DK, ML_DV), 0.5),
        'state_n': nrm(5, (DEC_BATCH, DEPTH, 2, ML_HEADS, ML_DK), 0.5),
        'state_m': nrm(6, (DEC_BATCH, DEPTH, 2, ML_HEADS), 1.0),
        'c': nrm(7, (DEC_BATCH, D_MODEL), 1.0),
        'c_ctx': nrm(8, (D_MODEL,), 1.0),
        'norm_w': 1.0 + nrm(9, (DEPTH, D_MODEL), 0.02),
        'w_mod': nrm(10, (DEPTH, D_MODEL, 3 * D_MODEL), 0.5 * D_MODEL ** -0.5),
        'b_mod': nrm(11, (DEPTH, 3 * D_MODEL), 0.02),
        'w_in': nrm(12, (DEPTH, D_MODEL, D_PROJ), D_MODEL ** -0.5),
        'b_if': f_off + nrm(13, (DEPTH, N_GATES), 0.1),
        'conv_w': nrm(14, (DEPTH, CONV_W, 2 * ML_W), CONV_W ** -0.5),
        'conv_b': nrm(15, (DEPTH, 2 * ML_W), 0.02),
        'q_norm': 1.0 + nrm(16, (DEPTH, HEAD_DIM), 0.02),
        'k_norm': 1.0 + nrm(17, (DEPTH, HEAD_DIM), 0.02),
        'ml_norm': 1.0 + nrm(18, (DEPTH, ML_W), 0.02),
        'w_fno': nrm(19, (DEPTH, FO_GROUPS, FO_GC, FO_GC), FO_GC ** -0.5),
        'w_out': nrm(20, (DEPTH, D_MIX, D_MODEL), D_MIX ** -0.5),
    }


def reference(x_prompt, x_sample, cache_k, cache_v, state_C, state_n, state_m, c, c_ctx,
              norm_w, w_mod, b_mod, w_in, b_if, conv_w, conv_b, q_norm, k_norm, ml_norm, w_fno, w_out):
    Bp = x_prompt.shape[0]
    zero_state = (jnp.zeros((Bp, 2, ML_HEADS, ML_DK, ML_DV), jnp.float32),
                  jnp.zeros((Bp, 2, ML_HEADS, ML_DK), jnp.float32),
                  jnp.zeros((Bp, 2, ML_HEADS), jnp.float32))
    xp = x_prompt
    new_k, new_v, new_C, new_n, new_m = [], [], [], [], []
    for l in range(DEPTH):
        lw = (norm_w[l], w_mod[l], b_mod[l], w_in[l], b_if[l], conv_w[l], conv_b[l],
              q_norm[l], k_norm[l], ml_norm[l], w_fno[l], w_out[l])
        xp, (k_l, v_l, C_l, n_l, m_l) = mixer_layer(xp, c_ctx[None, :], lw, None, zero_state, None)
        new_k.append(k_l)
        new_v.append(v_l)
        new_C.append(C_l)
        new_n.append(n_l)
        new_m.append(m_l)

    n_rows = x_sample.shape[1] // GRID_W
    xs = x_sample
    for l in range(DEPTH):
        lw = (norm_w[l], w_mod[l], b_mod[l], w_in[l], b_if[l], conv_w[l], conv_b[l],
              q_norm[l], k_norm[l], ml_norm[l], w_fno[l], w_out[l])
        xs, _ = mixer_layer(xs, c, lw, (cache_k[:, l], cache_v[:, l]),
                            (state_C[:, l], state_n[:, l], state_m[:, l]), n_rows)

    return (xp, xs, jnp.stack(new_k, axis=1), jnp.stack(new_v, axis=1), jnp.stack(new_C, axis=1),
            jnp.stack(new_n, axis=1), jnp.stack(new_m, axis=1))
```

```cpp
#include <hip/hip_runtime.h>
#include <hip/hip_cooperative_groups.h>
#include <cstdio>
#include <cstdint>
namespace cg = cooperative_groups;

namespace pg8 {
#define PG8_LAS __attribute__((address_space(3)))
typedef unsigned short bf16_t;
typedef short bf16x8 __attribute__((ext_vector_type(8)));
typedef float f32x4 __attribute__((ext_vector_type(4)));
typedef unsigned u32x4 __attribute__((ext_vector_type(4)));
constexpr int BM = 256, BK = 64, HALF = 128, HTB = HALF * BK * 2  , STAGE_BYTES = 8 * HTB, NXCD = 8, WGM = 8;

__host__ __device__ __forceinline__ int lds_byte(int r, int c) { const int st = (r >> 4) * 2 + (c >> 5), rr = r & 15, cc = c & 31, ob = rr * 64 + cc * 2; return st * 1024 + (ob ^ (((ob >> 9) & 1) << 5)); }
__host__ __device__ __forceinline__ void stage_rc(int b, int& R, int& C) { const int st = b / 1024, sb = b % 1024, swz = sb ^ (((sb >> 9) & 1) << 5); R = (st >> 1) * 16 + swz / 64; C = (st & 1) * 32 + (swz % 64) / 2; }
__host__ __device__ __forceinline__ int perm32(int rho) { const int n = rho >> 4, i = rho & 15; return 8 * (i >> 2) + 4 * n + (i & 3); }

struct Unit { int pm, pn; };
struct Gemm { const bf16_t* A; const bf16_t* Bt; int M, N, K; };

struct StaticOrder {
    int nM, nN, nwg, G, c;
    __host__ __device__ void init(int M, int N, int G_, int c_) { nM = M / BM; nN = N / BM; nwg = nM * nN; G = G_; c = c_; }
    __host__ __device__ bool next(int i, Unit& u) const {
        const long L = (long)i * G + c; if (L >= nwg) return false;
        int wgid = (int)L; { const int q = nwg / NXCD, r = nwg % NXCD, xcd = wgid % NXCD, off = wgid / NXCD; wgid = (xcd < r ? xcd * (q + 1) : r * (q + 1) + (xcd - r) * q) + off; }
        const int nig = WGM * nN, gid = wgid / nig, fm = gid * WGM, gsz = (nM - fm) < WGM ? (nM - fm) : WGM;
        u.pm = fm + ((wgid % nig) % gsz); u.pn = (wgid % nig) / gsz; return true;
    }
    __device__ __forceinline__ void a_ready(const Unit&) const {}
    __device__ __forceinline__ void done(const Unit&) const {}
};
__device__ __forceinline__ unsigned cvt_pk_bf16(float lo, float hi) { unsigned r; asm volatile("v_cvt_pk_bf16_f32 %0, %1, %2" : "=v"(r) : "v"(lo), "v"(hi)); return r; }

struct EpiZ {
    static constexpr bool PERM = true, AFTER_DRAIN = false;
    bf16_t* O; int ldc; float* nv;
    __device__ __forceinline__ void operator()(const f32x4 (&acc)[2][2][4][2], const Unit& u, int wr, int wc, int fr, int fq) const {
        const int row0 = u.pm * BM + wr * 64 + fr, col0 = u.pn * BM + wc * 32 + 8 * fq;
#pragma unroll
        for (int ai = 0; ai < 2; ++ai)
#pragma unroll
            for (int m = 0; m < 4; ++m) { bf16_t* rowp = O + (size_t)(row0 + ai * HALF + m * 16) * ldc + col0;
#pragma unroll
                for (int bj = 0; bj < 2; ++bj) { const f32x4 v0 = acc[ai][bj][m][0], v1 = acc[ai][bj][m][1];
                    u32x4 w; w.x = cvt_pk_bf16(v0[0], v0[1]); w.y = cvt_pk_bf16(v0[2], v0[3]); w.z = cvt_pk_bf16(v1[0], v1[1]); w.w = cvt_pk_bf16(v1[2], v1[3]);
                    *(u32x4*)(rowp + bj * HALF) = w;
                    if (u.pn == 5 && u.pm < 16) { const int row = row0 + ai * HALF + m * 16; float* o = nv + ((size_t)(row >> 8) * 512 + (row & 255)) * 256 + (col0 + bj * HALF - 1280); __builtin_nontemporal_store(v0, (f32x4*)o); __builtin_nontemporal_store(v1, (f32x4*)(o + 4)); } } }
    }
};
template <bool L1> struct EpiRes {
    static constexpr bool PERM = false, AFTER_DRAIN = false;
    const float* xa; const float* xb; const bf16_t* x1in; bf16_t* x1out; float* out; const float* mod;
    __device__ __forceinline__ void operator()(const f32x4 (&acc)[2][2][4][2], const Unit& u, int wr, int wc, int fr, int fq) const {
        const int row0 = u.pm * BM + wr * 64 + fr, col0 = u.pn * BM + wc * 32 + 4 * fq;
        const int ci = u.pm < 16 ? 0 : 1 + ((u.pm - 16) >> 2);
        const float* gate = mod + ci * 6144 + 4096;
        f32x4 gv[2][2];
#pragma unroll
        for (int bj = 0; bj < 2; ++bj)
#pragma unroll
            for (int n = 0; n < 2; ++n) gv[bj][n] = *(const f32x4*)(gate + col0 + bj * HALF + n * 16);
#pragma unroll
        for (int ai = 0; ai < 2; ++ai)
#pragma unroll
            for (int m = 0; m < 4; ++m) { const int r = row0 + ai * HALF + m * 16;
                const float* xin = (u.pm < 16) ? xa + (size_t)r * 2048 : xb + (size_t)(r - 4096) * 2048;
#pragma unroll
                for (int bj = 0; bj < 2; ++bj)
#pragma unroll
                    for (int n = 0; n < 2; ++n) { const int c = col0 + bj * HALF + n * 16;
                        if constexpr (L1) { const unsigned long long xw = __builtin_nontemporal_load((const unsigned long long*)(x1in + (size_t)r * 2048 + c));
                            f32x4 xv; xv[0] = __uint_as_float((unsigned)xw << 16); xv[1] = __uint_as_float((unsigned)xw & 0xffff0000u); xv[2] = __uint_as_float((unsigned)(xw >> 32) << 16); xv[3] = __uint_as_float((unsigned)(xw >> 32) & 0xffff0000u);
                            __builtin_nontemporal_store(xv + gv[bj][n] * acc[ai][bj][m][n], (f32x4*)(out + (size_t)r * 2048 + c)); }
                        else { const f32x4 xv = __builtin_nontemporal_load((const f32x4*)(xin + c)); const f32x4 y = xv + gv[bj][n] * acc[ai][bj][m][n];
                            const unsigned long long w = (unsigned long long)cvt_pk_bf16(y[0], y[1]) | ((unsigned long long)cvt_pk_bf16(y[2], y[3]) << 32);
                            *(unsigned long long*)(x1out + (size_t)r * 2048 + c) = w; } } }
    }
};
template <class Epi, class Sched, bool ALIGN_EPI = false, bool SP2 = false>
__device__ __forceinline__ void gemm_phase(PG8_LAS unsigned char* lds, const Gemm g, const Sched& S, const Epi& E) {
    int tid_ = threadIdx.x; asm volatile("" : "+v"(tid_));
    const int tid = tid_, wid = __builtin_amdgcn_readfirstlane(tid >> 6), lane = tid & 63, wr = wid >> 2, wc = wid & 3, fr = lane & 15, fq = lane >> 4;
    const int K = g.K, nt = K / BK;
    unsigned voffA[2], voffB[2];
#pragma unroll
    for (int i = 0; i < 2; ++i) { int R, C; stage_rc(tid * 16 + i * 8192, R, C); const int Rb = Epi::PERM ? ((R & ~31) + perm32(R & 31)) : R;
        voffA[i] = (unsigned)(R * K + C) * 2u; voffB[i] = (unsigned)(Rb * K + C) * 2u; }
    const size_t kstep = (size_t)(BK * 2);
    const size_t hstep = (size_t)HALF * K * 2;
    const size_t tstep = 2 * hstep;
    const unsigned ldsw = (unsigned)wid * 1024u;
    const int aoff = lds_byte(wr * 64 + fr, fq * 8), boff = lds_byte(wc * 32 + fr, fq * 8);
#define PG8_SA(b, h) (((b) * 2 + (h)) * HTB)
#define PG8_SB(b, h) ((4 + (b) * 2 + (h)) * HTB)
#define PG8_STAGE(bufoff, gbase, voff) do { _Pragma("unroll") for (int _i = 0; _i < 2; ++_i) \
        __builtin_amdgcn_global_load_lds((const unsigned*)((const char*)(gbase) + (voff)[_i]), (PG8_LAS unsigned*)(lds + (bufoff) + ldsw + _i * 8192), 16, 0, 0); } while (0)
#define PG8_LDA(dst, b, h) do { _Pragma("unroll") for (int m = 0; m < 4; ++m) _Pragma("unroll") for (int k = 0; k < 2; ++k) dst[m][k] = *(const PG8_LAS bf16x8*)(lds + PG8_SA(b, h) + aoff + m * 2048 + k * 1024); } while (0)
#define PG8_LDB(dst, b, h) do { _Pragma("unroll") for (int n = 0; n < 2; ++n) _Pragma("unroll") for (int k = 0; k < 2; ++k) dst[n][k] = *(const PG8_LAS bf16x8*)(lds + PG8_SB(b, h) + boff + n * 2048 + k * 1024); } while (0)
#define PG8_MMA(ai, bj, At, Bt) do { __builtin_amdgcn_s_setprio(1); _Pragma("unroll") for (int m = 0; m < 4; ++m) _Pragma("unroll") for (int n = 0; n < 2; ++n) _Pragma("unroll") for (int k = 0; k < 2; ++k) \
        acc[ai][bj][m][n] = __builtin_amdgcn_mfma_f32_16x16x32_bf16(Bt[n][k], At[m][k], acc[ai][bj][m][n], 0, 0, 0); __builtin_amdgcn_s_setprio(0); } while (0)
#define PG8_WAIT_V(n) asm volatile("s_waitcnt vmcnt(" #n ")" ::: "memory")
#define PG8_WAIT_L(n) asm volatile("s_waitcnt lgkmcnt(" #n ")" ::: "memory")
#define PG8_BAR __builtin_amdgcn_s_barrier()
#define PG8_SCHED __builtin_amdgcn_sched_barrier(0)
    Unit cur, nxt; int ui = 0;
    if (!S.next(0, cur)) return;
    f32x4 acc[2][2][4][2];
#pragma unroll
    for (int a = 0; a < 2; ++a)
#pragma unroll
        for (int b = 0; b < 2; ++b)
#pragma unroll
            for (int m = 0; m < 4; ++m)
#pragma unroll
                for (int n = 0; n < 2; ++n) acc[a][b][m][n] = (f32x4){0.f, 0.f, 0.f, 0.f};
    bf16x8 At[4][2], B0[2][2], B1[2][2];
    const char* cA = (const char*)g.A + (size_t)cur.pm * tstep; const char* cB = (const char*)g.Bt + (size_t)cur.pn * tstep;
    S.a_ready(cur);
    if constexpr (SP2) {
        PG8_STAGE(PG8_SB(0, 0), cB, voffB); PG8_STAGE(PG8_SB(0, 1), cB + hstep, voffB); PG8_STAGE(PG8_SA(0, 0), cA, voffA); PG8_STAGE(PG8_SA(0, 1), cA + hstep, voffA);
        if (wr == 1) PG8_BAR;
        PG8_WAIT_V(2); PG8_BAR;
        PG8_STAGE(PG8_SB(1, 0), cB + kstep, voffB); PG8_STAGE(PG8_SA(1, 0), cA + kstep, voffA); PG8_STAGE(PG8_SB(1, 1), cB + hstep + kstep, voffB);
        PG8_WAIT_V(6); PG8_BAR;
    } else {
        PG8_STAGE(PG8_SB(0, 0), cB, voffB); PG8_STAGE(PG8_SA(0, 0), cA, voffA); PG8_STAGE(PG8_SB(0, 1), cB + hstep, voffB); PG8_STAGE(PG8_SA(0, 1), cA + hstep, voffA);
        if (wr == 1) PG8_BAR;
        PG8_WAIT_V(4); PG8_BAR;
        PG8_STAGE(PG8_SB(1, 0), cB + kstep, voffB); PG8_STAGE(PG8_SA(1, 0), cA + kstep, voffA); PG8_STAGE(PG8_SB(1, 1), cB + hstep + kstep, voffB);
        PG8_WAIT_V(6); PG8_BAR;
    }
    for (;;) {
        const bool has_next = S.next(ui + 1, nxt);
        const char* nA = has_next ? (const char*)g.A + (size_t)nxt.pm * tstep : cA; const char* nB = has_next ? (const char*)g.Bt + (size_t)nxt.pn * tstep : cB;
        for (int t = 0; t < nt; t += 2) {
            const bool last = (t == nt - 2);
            const char* a1 = cA + (size_t)(t + 1) * kstep;
            const char* a2 = last ? nA : cA + (size_t)(t + 2) * kstep; const char* b2 = last ? nB : cB + (size_t)(t + 2) * kstep;
            const char* a3 = a2 + kstep; const char* b3 = b2 + kstep;
            if (last && has_next) S.a_ready(nxt);
            if constexpr (SP2) {
            PG8_LDB(B0, 0, 0); PG8_LDB(B1, 0, 1); PG8_SCHED; PG8_LDA(At, 0, 0); PG8_STAGE(PG8_SA(1, 1), a1 + hstep, voffA);
            PG8_WAIT_V(8); PG8_WAIT_L(0); PG8_BAR; PG8_MMA(0, 0, At, B0); PG8_MMA(0, 1, At, B1); PG8_BAR; PG8_SCHED;
            PG8_LDA(At, 0, 1); PG8_STAGE(PG8_SB(0, 0), b2, voffB); PG8_STAGE(PG8_SB(0, 1), b2 + hstep, voffB); PG8_STAGE(PG8_SA(0, 0), a2, voffA);
            PG8_WAIT_V(8); PG8_WAIT_L(0); PG8_BAR; PG8_MMA(1, 0, At, B0); PG8_MMA(1, 1, At, B1); PG8_BAR; PG8_SCHED;
            PG8_LDB(B0, 1, 0); PG8_LDB(B1, 1, 1); PG8_SCHED; PG8_LDA(At, 1, 0); PG8_STAGE(PG8_SA(0, 1), a2 + hstep, voffA);
            PG8_WAIT_V(8); PG8_WAIT_L(0); PG8_BAR; PG8_MMA(0, 0, At, B0); PG8_MMA(0, 1, At, B1); PG8_BAR; PG8_SCHED;
            PG8_LDA(At, 1, 1); PG8_STAGE(PG8_SB(1, 0), b3, voffB); PG8_STAGE(PG8_SB(1, 1), b3 + hstep, voffB); PG8_STAGE(PG8_SA(1, 0), a3, voffA);
            PG8_WAIT_V(8); PG8_WAIT_L(0); PG8_BAR; PG8_MMA(1, 0, At, B0); PG8_MMA(1, 1, At, B1); PG8_BAR; PG8_SCHED;
            } else {
            PG8_LDB(B0, 0, 0); PG8_SCHED; PG8_LDA(At, 0, 0); PG8_STAGE(PG8_SA(1, 1), a1 + hstep, voffA);
            PG8_WAIT_L(8); PG8_BAR; PG8_WAIT_L(0); PG8_MMA(0, 0, At, B0); PG8_BAR; PG8_SCHED;
            PG8_LDB(B1, 0, 1); PG8_STAGE(PG8_SB(0, 0), b2, voffB);
            PG8_BAR; PG8_WAIT_L(0); PG8_MMA(0, 1, At, B1); PG8_BAR;
            PG8_LDA(At, 0, 1); PG8_STAGE(PG8_SA(0, 0), a2, voffA);
            PG8_BAR; PG8_WAIT_L(0); PG8_MMA(1, 0, At, B0); PG8_BAR; PG8_SCHED;
            PG8_STAGE(PG8_SB(0, 1), b2 + hstep, voffB);
            PG8_WAIT_V(6); PG8_BAR; PG8_MMA(1, 1, At, B1); PG8_BAR;
            PG8_LDB(B0, 1, 0); PG8_SCHED; PG8_LDA(At, 1, 0); PG8_STAGE(PG8_SA(0, 1), a2 + hstep, voffA);
            PG8_WAIT_L(8); PG8_BAR; PG8_WAIT_L(0); PG8_MMA(0, 0, At, B0); PG8_BAR; PG8_SCHED;
            PG8_LDB(B1, 1, 1); PG8_STAGE(PG8_SB(1, 0), b3, voffB);
            PG8_BAR; PG8_WAIT_L(0); PG8_MMA(0, 1, At, B1); PG8_BAR;
            PG8_LDA(At, 1, 1); PG8_STAGE(PG8_SA(1, 0), a3, voffA);
            PG8_BAR; PG8_WAIT_L(0); PG8_MMA(1, 0, At, B0); PG8_BAR; PG8_SCHED;
            PG8_STAGE(PG8_SB(1, 1), b3 + hstep, voffB);
            PG8_WAIT_V(6); PG8_BAR; PG8_MMA(1, 1, At, B1); PG8_BAR;
            }
        }
        if constexpr (ALIGN_EPI) { if (wr == 0) PG8_BAR; }
        if constexpr (!Epi::AFTER_DRAIN) { E(acc, cur, wr, wc, fr, fq); S.done(cur); }
        if (!has_next) break;
#pragma unroll
        for (int a = 0; a < 2; ++a)
#pragma unroll
            for (int b = 0; b < 2; ++b)
#pragma unroll
                for (int m = 0; m < 4; ++m)
#pragma unroll
                    for (int n = 0; n < 2; ++n) acc[a][b][m][n] = (f32x4){0.f, 0.f, 0.f, 0.f};
        cur = nxt; cA = nA; cB = nB; ++ui;
        if constexpr (ALIGN_EPI) { if (wr == 1) PG8_BAR; }
    }
    PG8_WAIT_V(0);
    if constexpr (!ALIGN_EPI) { if (wr == 0) PG8_BAR; }
    PG8_BAR;
    if constexpr (Epi::AFTER_DRAIN) { E.fused(acc, cur, wr, wc, fr, fq, lds, wid, lane); S.done(cur); }
#undef PG8_SA
#undef PG8_SB
#undef PG8_STAGE
#undef PG8_LDA
#undef PG8_LDB
#undef PG8_MMA
#undef PG8_WAIT_V
#undef PG8_WAIT_L
#undef PG8_BAR
#undef PG8_SCHED
}

}

namespace att {
using bf16 = unsigned short;
constexpr int   D = 128, NW = 8, QBLK = 32, KVBLK = 64;
constexpr float SCALE = 0.088388347648318440f;
constexpr float THR = 8.f;
constexpr int SDEPTH = 1;
constexpr int LDQ = 128, LDK = 128;
constexpr size_t SHM_V = KVBLK * D * 2, SHM_K = KVBLK * D * 2, SHM_ATTN = 2 * SHM_V + 2 * SHM_K + NW * 64 * 4;
using bf16x8 = __attribute__((ext_vector_type(8))) short;
using s16x4  = __attribute__((ext_vector_type(4))) short;
using f32x16 = __attribute__((ext_vector_type(16))) float;
using f32x8  = __attribute__((ext_vector_type(8))) float;
using u32x4  = __attribute__((ext_vector_type(4))) unsigned;
#define KSWZ(row, colB) ((row) * 256 + ((colB) ^ (((row) & 7) << 4)))
#define SBAR() __builtin_amdgcn_sched_barrier(0)
__device__ __forceinline__ int crow(int r, int hi) { return (r & 3) + 8 * (r >> 2) + 4 * hi; }
__device__ __forceinline__ unsigned cvtpk(float lo, float hi) {
  unsigned r; asm volatile("v_cvt_pk_bf16_f32 %0, %1, %2" : "=v"(r) : "v"(lo), "v"(hi)); return r;
}
template <typename TIn> struct Stage;
template <> struct Stage<bf16>  { using T = bf16x8;
  __device__ static __forceinline__ T ld8(const bf16* p) { return *reinterpret_cast<const bf16x8*>(p); }
  __device__ static __forceinline__ bf16x8 tobf(T x) { return x; } };
template <> struct Stage<float> { using T = f32x8;
  __device__ static __forceinline__ T ld8(const float* p) { return *reinterpret_cast<const f32x8*>(p); }
  __device__ static __forceinline__ bf16x8 tobf(T x) {
    u32x4 w = {cvtpk(x[0], x[1]), cvtpk(x[2], x[3]), cvtpk(x[4], x[5]), cvtpk(x[6], x[7])}; return *reinterpret_cast<bf16x8*>(&w); } };

__device__ __forceinline__ void partialSM(f32x16& p0, f32x16& p1, float& m_reg, float& mn, float& alpha) {
  constexpr float C = SCALE * 1.4426950408889634f;
  float pmax = p0[0]; for (int r = 1; r < 16; ++r) pmax = fmaxf(pmax, p0[r]); for (int r = 0; r < 16; ++r) pmax = fmaxf(pmax, p1[r]);
  { auto rr = __builtin_amdgcn_permlane32_swap(__float_as_uint(pmax), __float_as_uint(pmax), false, false);
    pmax = fmaxf(__uint_as_float(rr[0]), __uint_as_float(rr[1])); }
  if (__builtin_expect(__all(pmax - m_reg <= THR / SCALE), 1)) { mn = m_reg; alpha = 1.f; }
  else { mn = fmaxf(m_reg, pmax); alpha = __builtin_amdgcn_exp2f((m_reg - mn) * C); m_reg = mn; }
  float mnC = -mn * C;
  for (int r = 0; r < 16; ++r) p0[r] = fmaf(p0[r], C, mnC); for (int r = 0; r < 16; ++r) p1[r] = fmaf(p1[r], C, mnC);
  for (int r = 0; r < 16; ++r) p0[r] = __builtin_amdgcn_exp2f(p0[r]);
}
__device__ __forceinline__ void finishSM(f32x16& p0, f32x16& p1, float alpha, float& l_reg, bf16x8& pa0, bf16x8& pa1, bf16x8& pa2, bf16x8& pa3) {
  for (int r = 0; r < 16; ++r) p1[r] = __builtin_amdgcn_exp2f(p1[r]);
  float ps = 0; for (int r = 0; r < 16; ++r) ps += p0[r]; for (int r = 0; r < 16; ++r) ps += p1[r];
  { auto rr = __builtin_amdgcn_permlane32_swap(__float_as_uint(ps), __float_as_uint(ps), false, false);
    ps = __uint_as_float(rr[0]) + __uint_as_float(rr[1]); }
  l_reg = l_reg * alpha + ps;
#define PK4(P, BASE, OUT) do { unsigned a0 = cvtpk(P[BASE + 0], P[BASE + 1]), a1 = cvtpk(P[BASE + 2], P[BASE + 3]);   \
    unsigned b0 = cvtpk(P[BASE + 4], P[BASE + 5]), b1 = cvtpk(P[BASE + 6], P[BASE + 7]);                              \
    auto r0 = __builtin_amdgcn_permlane32_swap(a0, b0, false, false); auto r1 = __builtin_amdgcn_permlane32_swap(a1, b1, false, false); \
    u32x4 w = {r0[0], r1[0], r0[1], r1[1]}; OUT = *reinterpret_cast<bf16x8*>(&w); } while (0)
  PK4(p0, 0, pa0); PK4(p0, 8, pa1); PK4(p1, 0, pa2); PK4(p1, 8, pa3);
#undef PK4
}
__device__ __forceinline__ void qkt(f32x16& p0, f32x16& p1, const bf16* Ks, const bf16x8* qr, int r32, int hi) {
  p0 = f32x16{}; p1 = f32x16{};
  for (int d0 = 0; d0 < 8; ++d0) { int cb = (d0 * 16 + hi * 8) * 2;
    bf16x8 b0 = *reinterpret_cast<const bf16x8*>((const char*)Ks + KSWZ(r32, cb));
    bf16x8 b1 = *reinterpret_cast<const bf16x8*>((const char*)Ks + KSWZ(32 + r32, cb));
    p0 = __builtin_amdgcn_mfma_f32_32x32x16_bf16(b0, qr[d0], p0, 0, 0, 0);
    p1 = __builtin_amdgcn_mfma_f32_32x32x16_bf16(b1, qr[d0], p1, 0, 0, 0); }
}
__device__ __forceinline__ int v_st(int k, int c) { const int kk = (k & ~0xC) | ((k & 4) << 1) | ((k & 8) >> 1); return ((kk >> 3) * 4 + (c >> 5)) * 512 + ((kk & 7) * 32 + (c & 31)) * 2; }
__device__ __forceinline__ int v_rd_base(int lane) { return ((lane & 3) << 3) | (((lane >> 2) & 3) << 6) | (((lane >> 4) & 1) << 5) | (((lane >> 5) & 1) << 8); }
constexpr int v_rd_off(int d0, int ks, int half) { return d0 * 512 + ks * 4096 + half * 2048; }
template <int OFF> __device__ __forceinline__ s16x4 tr_read(int vb) {
  s16x4 r; asm volatile("ds_read_b64_tr_b16 %0, %1 offset:%2" : "=&v"(r) : "v"(vb), "i"(OFF) : "memory"); return r;
}
template <int D0> __device__ __forceinline__ void pv_one(f32x16& od, int vb, bf16x8 pa0, bf16x8 pa1, bf16x8 pa2, bf16x8 pa3) {
  const s16x4 l0 = tr_read<v_rd_off(D0, 0, 0)>(vb), h0 = tr_read<v_rd_off(D0, 0, 1)>(vb), l1 = tr_read<v_rd_off(D0, 1, 0)>(vb), h1 = tr_read<v_rd_off(D0, 1, 1)>(vb);
  const s16x4 l2 = tr_read<v_rd_off(D0, 2, 0)>(vb), h2 = tr_read<v_rd_off(D0, 2, 1)>(vb), l3 = tr_read<v_rd_off(D0, 3, 0)>(vb), h3 = tr_read<v_rd_off(D0, 3, 1)>(vb);
  asm volatile("s_waitcnt lgkmcnt(0)" ::: "memory"); SBAR();
#define PK(L, H) (bf16x8){L[0], L[1], L[2], L[3], H[0], H[1], H[2], H[3]}
  od = __builtin_amdgcn_mfma_f32_32x32x16_bf16(pa0, PK(l0, h0), od, 0, 0, 0);
  od = __builtin_amdgcn_mfma_f32_32x32x16_bf16(pa1, PK(l1, h1), od, 0, 0, 0);
  od = __builtin_amdgcn_mfma_f32_32x32x16_bf16(pa2, PK(l2, h2), od, 0, 0, 0);
  od = __builtin_amdgcn_mfma_f32_32x32x16_bf16(pa3, PK(l3, h3), od, 0, 0, 0);
#undef PK
}
__device__ __forceinline__ void pv_d0(f32x16* o, int vb, bf16x8 pa0, bf16x8 pa1, bf16x8 pa2, bf16x8 pa3) {
  pv_one<0>(o[0], vb, pa0, pa1, pa2, pa3); pv_one<1>(o[1], vb, pa0, pa1, pa2, pa3); pv_one<2>(o[2], vb, pa0, pa1, pa2, pa3); pv_one<3>(o[3], vb, pa0, pa1, pa2, pa3);
}


__device__ __forceinline__ void attn_dense_body(const bf16* __restrict__ Qb, const bf16* __restrict__ Kh, const bf16* __restrict__ Vc, const bf16* __restrict__ Vz, int vsplit,
                                                const float* __restrict__ qnw, const float* __restrict__ rope, int tq0, bool do_rope,
                                                bf16* __restrict__ Mix, const bf16* __restrict__ Ag, int seq, char* lds) {
  using TQ = bf16;
  using St = Stage<bf16>; using SQ = Stage<TQ>;
  int tid_ = threadIdx.x; asm volatile("" : "+v"(tid_));
  const int tid = tid_, wid = tid >> 6, lane = tid & 63, r32 = lane & 31, hi = lane >> 5;
  bf16* V_lds = (bf16*)lds; bf16* K_lds = (bf16*)(lds + 2 * SHM_V);
  float* ws = (float*)(lds + 2 * SHM_V + 2 * SHM_K) + wid * 64; float* li_l = ws; float* al_l = ws + 32;
  float m_reg = -1e30f, l_reg = 0; f32x16 o[4] = {}; bf16x8 qr[8];
  const TQ* Qw = Qb + (long)(wid * QBLK + r32) * 6144 + hi * 8;
#pragma unroll
  for (int d0 = 0; d0 < 8; ++d0) qr[d0] = SQ::tobf(SQ::ld8(Qw + d0 * 16));
  {
    float xq[8][8]; float ss = 0.f;
#pragma unroll
    for (int d0 = 0; d0 < 8; ++d0)
#pragma unroll
      for (int j = 0; j < 8; ++j) { xq[d0][j] = __uint_as_float(((unsigned)(unsigned short)qr[d0][j]) << 16); ss += xq[d0][j] * xq[d0][j]; }
    ss += __shfl_xor(ss, 32);
    const float rstd = rsqrtf(ss * (1.f / 128.f) + 1e-6f);
#pragma unroll
    for (int d0 = 0; d0 < 8; ++d0) { const float* wp = qnw + d0 * 16 + hi * 8;
#pragma unroll
      for (int j = 0; j < 8; ++j) xq[d0][j] *= rstd * wp[j]; }
    if (do_rope) { const int t = tq0 + wid * QBLK + r32, prow = t >> 6, pcol = t & 63;
#pragma unroll
      for (int g = 0; g < 2; ++g)
#pragma unroll
        for (int e = 0; e < 2; ++e) { const int d0 = 4 * g + e; const float* cs = rope + ((g ? pcol : prow) * 32 + 16 * e + 8 * hi) * 2;
#pragma unroll
          for (int j = 0; j < 8; ++j) { const float c = cs[2 * j], sn = cs[2 * j + 1], y1 = xq[d0][j], y2 = xq[d0 + 2][j];
            xq[d0][j] = y1 * c - y2 * sn; xq[d0 + 2][j] = y1 * sn + y2 * c; } } }
#pragma unroll
    for (int d0 = 0; d0 < 8; ++d0) { u32x4 w = {cvtpk(xq[d0][0], xq[d0][1]), cvtpk(xq[d0][2], xq[d0][3]), cvtpk(xq[d0][4], xq[d0][5]), cvtpk(xq[d0][6], xq[d0][7])}; qr[d0] = *reinterpret_cast<bf16x8*>(&w); }
  }
  const int voffc = (tid >> 4) * 128 + (tid & 15) * 8;
  const int sr = tid >> 4, sc = (tid & 15) * 8, vst0 = v_st(sr, sc), vst1 = v_st(32 + sr, sc);
  const int vb0 = (int)(uintptr_t)V_lds + v_rd_base(lane);
  struct { typename St::T vs0, vs1, ks0, ks1; } sr_[SDEPTH];
#define SLOAD(i, k0) do { const bool vc_ = (k0) < vsplit; const bf16* vb_ = vc_ ? Vc + (long)(k0) * 128 : Vz + (long)((k0) - vsplit) * 6144; const int vo_ = vc_ ? voffc : voffc + (tid >> 4) * 6016, v32_ = vc_ ? 32 * 128 : 32 * 6144; \
    sr_[i].vs0 = St::ld8(&vb_[vo_]); sr_[i].vs1 = St::ld8(&vb_[vo_ + v32_]); \
    sr_[i].ks0 = St::ld8(&Kh[(long)((k0) + sr) * LDK + sc]); sr_[i].ks1 = St::ld8(&Kh[(long)((k0) + 32 + sr) * LDK + sc]); } while (0)
#define SWRITE(b, i) do { *(bf16x8*)((char*)V_lds + (b) * SHM_V + vst0) = St::tobf(sr_[i].vs0);          \
    *(bf16x8*)((char*)V_lds + (b) * SHM_V + vst1) = St::tobf(sr_[i].vs1); int kc = sc * 2;               \
    *(bf16x8*)((char*)K_lds + (b) * SHM_K + KSWZ(sr, kc)) = St::tobf(sr_[i].ks0);                       \
    *(bf16x8*)((char*)K_lds + (b) * SHM_K + KSWZ(32 + sr, kc)) = St::tobf(sr_[i].ks1); } while (0)
#define SWAIT() do { if constexpr (SDEPTH == 2) asm volatile("s_waitcnt vmcnt(4)" ::: "memory"); else asm volatile("s_waitcnt vmcnt(0)" ::: "memory"); } while (0)
#define RESC(a) do { if (__any((a) < 1.f)) { if (hi == 0) al_l[r32] = (a); asm volatile("s_waitcnt lgkmcnt(0)" ::: "memory"); \
    for (int d = 0; d < 4; ++d) for (int r = 0; r < 16; ++r) o[d][r] *= al_l[crow(r, hi)]; } } while (0)
  f32x16 pA0, pA1, pB0, pB1; float mnA, mnB, alA, alB; bf16x8 pa0, pa1, pa2, pa3; const int NT = seq / KVBLK;
  constexpr int SE = 0, SO = SDEPTH - 1;
  SLOAD(SE, 0); asm volatile("s_waitcnt vmcnt(0)" ::: "memory"); SWRITE(0, SE); __syncthreads();
  qkt(pA0, pA1, K_lds, qr, r32, hi); partialSM(pA0, pA1, m_reg, mnA, alA);
  SLOAD(SO, KVBLK); if constexpr (SDEPTH == 2) { if (2 < NT) SLOAD(SE, 2 * KVBLK); }
  SWAIT(); SWRITE(1, SO); __syncthreads();
  for (int j = 1; j + 1 < NT; j += 2) {
    SBAR(); qkt(pB0, pB1, (bf16*)((char*)K_lds + SHM_K), qr, r32, hi);
    finishSM(pA0, pA1, alA, l_reg, pa0, pa1, pa2, pa3); SBAR();
    SLOAD(SO, (j + SDEPTH) * KVBLK); SBAR();
    pv_d0(o, vb0, pa0, pa1, pa2, pa3); partialSM(pB0, pB1, m_reg, mnB, alB);
    __syncthreads(); SWAIT(); SWRITE(0, SE);
    RESC(alB); __syncthreads();
    SBAR(); qkt(pA0, pA1, K_lds, qr, r32, hi);
    finishSM(pB0, pB1, alB, l_reg, pa0, pa1, pa2, pa3); SBAR();
    if (SDEPTH == 1 || j + 3 < NT) SLOAD(SE, (j + 1 + SDEPTH) * KVBLK); SBAR();
    pv_d0(o, vb0 + (int)SHM_V, pa0, pa1, pa2, pa3); partialSM(pA0, pA1, m_reg, mnA, alA);
    __syncthreads(); SWAIT(); SWRITE(1, SO);
    RESC(alA); __syncthreads();
  }
  SBAR(); qkt(pB0, pB1, (bf16*)((char*)K_lds + SHM_K), qr, r32, hi);
  finishSM(pA0, pA1, alA, l_reg, pa0, pa1, pa2, pa3); SBAR();
  pv_d0(o, vb0, pa0, pa1, pa2, pa3); partialSM(pB0, pB1, m_reg, mnB, alB);
  __syncthreads(); RESC(alB);
  finishSM(pB0, pB1, alB, l_reg, pa0, pa1, pa2, pa3); SBAR();
  pv_d0(o, vb0 + (int)SHM_V, pa0, pa1, pa2, pa3);
  if (hi == 0) li_l[r32] = l_reg; asm volatile("s_waitcnt lgkmcnt(0)" ::: "memory");
  float rli[16];
#pragma unroll
  for (int r = 0; r < 16; ++r) rli[r] = __builtin_amdgcn_rcpf(li_l[crow(r, hi)]);
  bf16* Mw = Mix + (long)(wid * QBLK) * 2048; const bf16* Aw = Ag + (long)(wid * QBLK) * 6144;
#pragma unroll
  for (int r = 0; r < 16; ++r) { int orow = crow(r, hi);
#pragma unroll
    for (int d0 = 0; d0 < 4; ++d0) { const float g = __uint_as_float(((unsigned)Aw[(long)orow * 6144 + d0 * 32 + r32]) << 16);
      const float val = o[d0][r] * rli[r] * (g * __builtin_amdgcn_rcpf(1.f + __expf(-g)));
      Mw[(long)orow * 2048 + d0 * 32 + r32] = (bf16)cvtpk(val, val); } }
#undef SLOAD
#undef SWRITE
#undef SWAIT
#undef RESC
}

}

#define DI __device__ __forceinline__
#define LAS __attribute__((address_space(3)))
typedef unsigned short bf16_t;
typedef short bf16x8 __attribute__((ext_vector_type(8)));
typedef float f32x4 __attribute__((ext_vector_type(4)));
typedef float f32x16 __attribute__((ext_vector_type(16)));
typedef unsigned u32x4 __attribute__((ext_vector_type(4)));
typedef unsigned u32x2 __attribute__((ext_vector_type(2)));
#define TID_SETUP int tid = threadIdx.x; asm volatile("" : "+v"(tid)); const int lane = tid & 63, wave = __builtin_amdgcn_readfirstlane(tid >> 6); (void)lane; (void)wave;
#define MFMA32(a, b, c) __builtin_amdgcn_mfma_f32_32x32x16_bf16((a), (b), (c), 0, 0, 0)

#define XB_TMO      128
#define XB_XCNT(j)  (256  + 64 * (j))
#define XB_XSUB(j)  (1280 + 64 * (j))
#define XB_XGEN(j)  (2304 + 64 * (j))
#define XB_TOP      3328
#define XB_TOPGEN   3392
#define XCD_BAR_WORDS 3456
#define XB_SPIN_CAP (1u << 18)
__device__ __forceinline__ unsigned xb_ld(unsigned* p)              { return __hip_atomic_load(p, __ATOMIC_RELAXED, __HIP_MEMORY_SCOPE_AGENT); }
__device__ __forceinline__ unsigned xb_add(unsigned* p, unsigned v) { return __hip_atomic_fetch_add(p, v, __ATOMIC_RELAXED, __HIP_MEMORY_SCOPE_AGENT); }
__device__ __forceinline__ unsigned xb_xcc_id() { return (unsigned)__builtin_amdgcn_s_getreg((3 << 11) | 20) & 0xFu; }
#define XB_SPIN(cond, bar) do { unsigned _sp = 0; while (cond) { __builtin_amdgcn_s_sleep(1); \
    if ((++_sp & 255u) == 0u) { if (xb_ld(&(bar)[XB_TMO])) break; if (_sp > XB_SPIN_CAP) { atomicAdd(&(bar)[XB_TMO], 1u); break; } } } } while (0)

struct XcdBarrier {
    unsigned* bar; unsigned x;
    volatile LAS unsigned* st;
};

__device__ __forceinline__ XcdBarrier xcd_barrier_post(unsigned* bar, volatile LAS unsigned* st) {
    XcdBarrier b; b.bar = bar; b.x = xb_xcc_id(); b.st = st;
    if (threadIdx.x == 0) (void)xb_add(&bar[XB_XCNT(b.x)], 1u);
    return b;
}
__device__ __forceinline__ void xcd_barrier_complete(unsigned* bar, unsigned x, unsigned& nloc, unsigned& nx) {
    const unsigned G = gridDim.x * gridDim.y * gridDim.z;
    unsigned sum, cnt, mine, sp = 0u;
    for (;;) {
        sum = 0u; cnt = 0u; mine = 0u;
#pragma unroll
        for (unsigned j = 0; j < 16; ++j) { const unsigned c = xb_ld(&bar[XB_XCNT(j)]); sum += c; cnt += (c > 0u) ? 1u : 0u; mine = (j == x) ? c : mine; }
        if (sum == G) break;
        __builtin_amdgcn_s_sleep(1);
        if ((++sp & 255u) == 0u) { if (xb_ld(&bar[XB_TMO])) break; if (sp > XB_SPIN_CAP) { atomicAdd(&bar[XB_TMO], 1u); break; } }
    }
    nloc = mine > 0u ? mine : 1u; nx = cnt > 0u ? cnt : 1u;
}

__device__ __forceinline__ void xcd_barrier(const XcdBarrier& b) {
    asm volatile("s_waitcnt vmcnt(0)" ::: "memory");
    __syncthreads();
    if (threadIdx.x == 0) {
        unsigned* bar = b.bar;
        __builtin_amdgcn_s_waitcnt(0);
        unsigned nloc = b.st[0], nx = b.st[1];
        if (nloc == 0u) { xcd_barrier_complete(bar, b.x, nloc, nx); b.st[0] = nloc; b.st[1] = nx; }
        const unsigned old = xb_add(&bar[XB_XSUB(b.x)], 1u);
        const unsigned gen = old / nloc;
        if (old + 1u == (gen + 1u) * nloc) {
            __builtin_amdgcn_fence(__ATOMIC_RELEASE, "agent");
            asm volatile("s_waitcnt vmcnt(0)" ::: "memory");
            const unsigned og = xb_add(&bar[XB_TOP], 1u);
            const unsigned tg = og / nx;
            if (og + 1u == (tg + 1u) * nx) xb_add(&bar[XB_TOPGEN], 1u);
            else XB_SPIN(xb_ld(&bar[XB_TOPGEN]) == tg, bar);
            __builtin_amdgcn_fence(__ATOMIC_ACQUIRE, "agent");
            xb_add(&bar[XB_XGEN(b.x)], 1u);
            asm volatile("s_waitcnt vmcnt(0)" ::: "memory");
        } else {
            XB_SPIN(xb_ld(&bar[XB_XGEN(b.x)]) == gen, bar);
            __builtin_amdgcn_fence(__ATOMIC_ACQUIRE, "agent");
            asm volatile("s_waitcnt vmcnt(0)" ::: "memory");
        }
    }
    __syncthreads();
}

constexpr int NTOK = 8192, DM = 2048, NZ = 6144;
constexpr int ZQ = 0, ZK = 1024, ZV = 1280, ZAG = 1536, ZMQ = 2560, ZMK = 3072, ZMV = 3584, ZMO = 4096, ZMG = 4608, ZFX = 5120, ZFG = 5632;
constexpr float EPS = 1e-6f;
constexpr size_t O_YP = 0, O_YS = 8388608, O_NK = 16777216, O_NV = 18874368, O_NC = 20971520, O_NN = 25165824, O_NM = 25198592, O_END = 25198848;
constexpr size_t WS_CTL = 0;
constexpr size_t WS_BAR = 16384;
constexpr size_t WS_MOD = 32768;
constexpr size_t WS_GATES = WS_MOD + 245760;
constexpr size_t WS_ROPE = WS_GATES + 524288;
constexpr size_t WS_WG = WS_ROPE + 16384;
constexpr size_t WS_CSW = WS_WG + 131072;
constexpr size_t WS_DFTC = WS_CSW + 524288;
constexpr size_t WS_DFTL = WS_DFTC + 262144;
constexpr size_t WS_WINT = WS_DFTL + 4194304;
constexpr size_t WS_WOUTT = WS_WINT + 50331648;
constexpr size_t WS_H = WS_WOUTT + 16777216;
constexpr size_t WS_Z = WS_H + 33554432;
constexpr size_t WS_Q = WS_Z + 100663296;
constexpr size_t WS_K = WS_Q + 16777216;
constexpr size_t WS_V = WS_K + 8388608;
constexpr size_t WS_MQ = WS_V + 8388608;
constexpr size_t WS_X1B = WS_MQ;
constexpr size_t WS_MK = WS_MQ + 8388608;
constexpr size_t WS_MKT = WS_MK + 8388608;
constexpr size_t WS_MVT = WS_MKT + 8388608;
constexpr size_t WS_XT = WS_MVT + 8388608;
constexpr size_t WS_GS = WS_XT + 8388608;
constexpr size_t WS_DEC = WS_GS + 1310720;
constexpr size_t WS_U = WS_DEC + 4096;
constexpr size_t WS_UN = WS_U + 67108864;
constexpr size_t WS_CJ = WS_UN + 524288;
constexpr size_t WS_NJ = WS_CJ + 33554432;
constexpr size_t WS_END = WS_NJ + 524288;
constexpr int KC_ELEMS = 16 * 2 * 256 * 128;
constexpr int KL_ELEMS = 4 * 2 * 1536 * 128;
constexpr int LDS_MISC = 151552;
constexpr int LDS_BYTES = LDS_MISC + 256;

struct P { const float* in[21]; float* out; unsigned char* ws; };
enum { I_XP = 0, I_XS, I_CK, I_CV, I_SC, I_SN, I_SM, I_C, I_CCTX, I_NORMW, I_WMOD, I_BMOD, I_WIN, I_BIF, I_CONVW, I_CONVB, I_QN, I_KN, I_MLN, I_WFNO, I_WOUT };

DI unsigned pk2(float lo, float hi) { unsigned r; asm volatile("v_cvt_pk_bf16_f32 %0, %1, %2" : "=v"(r) : "v"(lo), "v"(hi)); return r; }
DI float bf2f(bf16_t v) { return __uint_as_float(((unsigned)v) << 16); }
DI float bfs2f(short v) { return __uint_as_float(((unsigned)(unsigned short)v) << 16); }
DI bf16_t f2bf(float f) { unsigned r; asm("v_cvt_pk_bf16_f32 %0, %1, %1" : "=v"(r) : "v"(f)); return (bf16_t)r; }
typedef __bf16 bf16x2_t __attribute__((ext_vector_type(2)));
DI float dot2bf(unsigned a, unsigned b, float c) { return __builtin_amdgcn_fdot2_f32_bf16(__builtin_bit_cast(bf16x2_t, a), __builtin_bit_cast(bf16x2_t, b), c, false); }
DI float wave_sum(float v) {
#pragma unroll
    for (int o = 1; o < 64; o <<= 1) v += __shfl_xor(v, o);
    return v;
}
DI float silu_f(float x) { return x * __builtin_amdgcn_rcpf(1.f + __expf(-x)); }
DI float sigm_f(float x) { return __builtin_amdgcn_rcpf(1.f + __expf(-x)); }
DI int crow(int reg, int h) { return (reg & 3) + 8 * (reg >> 2) + 4 * h; }
DI bf16x8 pack8(const float* v) { u32x4 w; w.x = pk2(v[0], v[1]); w.y = pk2(v[2], v[3]); w.z = pk2(v[4], v[5]); w.w = pk2(v[6], v[7]); return __builtin_bit_cast(bf16x8, w); }

DI void transpose_item(const float* W, int ldw, int K, bf16_t* WT, int k0, int col_src, int row_dst, LAS float* scr, int lane) {
#pragma unroll 16
    for (int i = 0; i < 32; ++i) { const int kk = 2 * i + (lane >> 5); scr[kk * 33 + (lane & 31)] = __builtin_nontemporal_load(&W[(size_t)(k0 + kk) * ldw + col_src + (lane & 31)]); }
    asm volatile("s_waitcnt lgkmcnt(0)" ::: "memory");
    const int c = lane & 7;
#pragma unroll
    for (int j = 0; j < 4; ++j) { const int n = (lane >> 3) + 8 * j; const LAS float* s = scr + (8 * c) * 33 + n;
        u32x4 o; o.x = pk2(s[0 * 33], s[1 * 33]); o.y = pk2(s[2 * 33], s[3 * 33]); o.z = pk2(s[4 * 33], s[5 * 33]); o.w = pk2(s[6 * 33], s[7 * 33]);
        *(u32x4*)(WT + (size_t)(row_dst + n) * K + k0 + 8 * c) = o; }
    asm volatile("s_waitcnt lgkmcnt(0)" ::: "memory");
}

DI void phase0(const P& p, LAS unsigned char* lds, int ctr_idx) {
    TID_SETUP
    unsigned char* ws = p.ws;
    const int G = gridDim.x, bid = blockIdx.x;
    const int gt = bid * 512 + tid, NT = G * 512;
    {
        float* rope = (float*)(ws + WS_ROPE);
        for (int i = gt; i < 2048; i += NT) { const int pos = i >> 5, f = i & 31; const float inv = exp2f(-(float)f * (13.287712379549449f / 32.f));
            float s, c; sincosf((float)pos * inv, &s, &c); rope[2 * i] = c; rope[2 * i + 1] = s; }
        bf16_t* dc = (bf16_t*)(ws + WS_DFTC);
        for (int i = gt; i < 65536; i += NT) { const int a = i >> 8, b = i & 255, m = (a * b) & 255; float s, c; sincospif((float)m * (2.f / 256.f), &s, &c);
            const float sc = 0.005524271728019903f; dc[i] = f2bf(c * sc); dc[65536 + i] = f2bf(s * sc); }
        bf16_t* dl = (bf16_t*)(ws + WS_DFTL);
        for (int i = gt; i < 1048576; i += NT) { const int a = i >> 10, b = i & 1023, m = (a * b) & 1023; float s, c; sincospif((float)m * (2.f / 1024.f), &s, &c);
            const float sc = 0.0027621358640099515f; dl[i] = f2bf(c * sc); dl[1048576 + i] = f2bf(s * sc); }
        bf16_t* wg = (bf16_t*)(ws + WS_WG); const float* win = p.in[I_WIN];
        for (int i = gt; i < 65536; i += NT) { const int l = i >> 15, n = (i >> 11) & 15, k = i & 2047; wg[i] = f2bf(win[((size_t)l * 2048 + k) * 6160 + 5120 + n]); }
        const float* ck = p.in[I_CK]; const float* cv = p.in[I_CV];
        bf16_t* Kb = (bf16_t*)(ws + WS_K) + KC_ELEMS; bf16_t* Vb = (bf16_t*)(ws + WS_V) + KC_ELEMS;
        for (int i = gt; i < 131072; i += NT) { const int d8 = i & 15, key = (i >> 4) & 511, kvh = (i >> 13) & 1, b = (i >> 14) & 3, l = i >> 16;
            const size_t src = ((((size_t)b * 2 + l) * 512 + key) * 2 + kvh) * 128 + d8 * 8;
            const size_t dst = (size_t)l * KL_ELEMS + ((size_t)(b * 2 + kvh) * 1536 + key) * 128 + d8 * 8;
            const f32x4 a0 = *(const f32x4*)(ck + src), a1 = *(const f32x4*)(ck + src + 4), b0 = *(const f32x4*)(cv + src), b1 = *(const f32x4*)(cv + src + 4);
            u32x4 wk_, wv_; wk_.x = pk2(a0[0], a0[1]); wk_.y = pk2(a0[2], a0[3]); wk_.z = pk2(a1[0], a1[1]); wk_.w = pk2(a1[2], a1[3]);
            wv_.x = pk2(b0[0], b0[1]); wv_.y = pk2(b0[2], b0[3]); wv_.z = pk2(b1[0], b1[1]); wv_.w = pk2(b1[2], b1[3]);
            *(u32x4*)(Kb + dst) = wk_; *(u32x4*)(Vb + dst) = wv_; }
    }
    for (int u = bid; u < 256; u += G) {
        const int lg = u >> 5, jr = u & 31;
        LAS float* Wl = (LAS float*)lds; LAS float* ct = (LAS float*)(lds + 65536);
        const float* wf = p.in[I_WFNO] + (size_t)lg * 16384;
        for (int i = tid; i < 4096; i += 512) ((LAS f32x4*)Wl)[i] = ((const f32x4*)wf)[i];
        if (tid < 128) ct[tid] = cospif((float)tid * (1.f / 64.f));
        __syncthreads();
        bf16_t* csw = (bf16_t*)(ws + WS_CSW);
#pragma unroll
        for (int i = 0; i < 2; ++i) { const int e = tid + 512 * i, d = e & 127, j = 8 * jr + (e >> 7); const int c = j & 127, sh = (j >= 128) ? 32 : 0;
            float acc = 0.f;
#pragma unroll 8
            for (int cp = 0; cp < 128; ++cp) acc += ct[((c * cp) - sh) & 127] * Wl[cp * 128 + d];
            csw[((size_t)lg * 128 + d) * 256 + j] = f2bf(sh ? -acc : acc); }
        __syncthreads();
    }
    for (int t = bid; t < 192; t += G) {
        const int l = t / 96, col0 = (t % 96) * 64;
        LAS float* sc = (LAS float*)lds; LAS float* red = (LAS float*)(lds + 40960);
        for (int i = tid; i < 5 * 2048; i += 512) { const int ci = i >> 11, k = i & 2047; const float cvv = ci == 0 ? p.in[I_CCTX][k] : p.in[I_C][(ci - 1) * 2048 + k]; sc[i] = cvv / (1.f + expf(-cvv)); }
        __syncthreads();
        const int cq = lane & 15, kr = lane >> 4;
        const float* wp = p.in[I_WMOD] + (size_t)l * 2048 * 6144 + col0 + 4 * cq;
        f32x4 acc[5];
#pragma unroll
        for (int ci = 0; ci < 5; ++ci) acc[ci] = (f32x4){0.f, 0.f, 0.f, 0.f};
#pragma unroll 8
        for (int it = 0; it < 64; ++it) { const int k = wave * 4 + kr + 32 * it; const f32x4 wv = __builtin_nontemporal_load((const f32x4*)(wp + (size_t)k * 6144));
#pragma unroll
            for (int ci = 0; ci < 5; ++ci) acc[ci] += wv * sc[ci * 2048 + k]; }
#pragma unroll
        for (int ci = 0; ci < 5; ++ci)
#pragma unroll
            for (int j = 0; j < 4; ++j) { float v = acc[ci][j]; v += __shfl_xor(v, 16); v += __shfl_xor(v, 32); if (kr == 0) red[(wave * 20 + ci * 4 + j) * 16 + cq] = v; }
        __syncthreads();
        if (tid < 320) { const int ci = tid >> 6, cc = tid & 63, cq2 = cc >> 2, j = cc & 3; float s = 0.f;
#pragma unroll
            for (int w = 0; w < 8; ++w) s += red[(w * 20 + ci * 4 + j) * 16 + cq2];
            ((float*)(ws + WS_MOD))[(size_t)(l * 5 + ci) * 6144 + col0 + cc] = s + p.in[I_BMOD][l * 6144 + col0 + cc]; }
        __syncthreads();
    }
    {
        LAS float* scr = (LAS float*)(lds + wave * 8448);
        unsigned* ctr = (unsigned*)(ws + WS_CTL) + ctr_idx;
        for (;;) {
            unsigned base = 0; if (lane == 0) base = atomicAdd(ctr, 8u); base = __builtin_amdgcn_readfirstlane(base);
            if (base >= 16384u) break;
#pragma unroll 1
            for (unsigned q = 0; q < 8; ++q) { const unsigned it = base + q;
                if (it < 12288u) { const int l = it / 6144, r = it % 6144, kb = r / 192, nb = r % 192; const int n0 = nb * 32;
                    transpose_item(p.in[I_WIN] + (size_t)l * 2048 * 6160, 6160, 2048, (bf16_t*)(ws + WS_WINT) + (size_t)l * 6144 * 2048, kb * 64, n0 + (n0 >= 5120 ? 16 : 0), n0, scr, lane); }
                else { const int r0 = it - 12288, l = r0 / 2048, r = r0 % 2048, kb = r / 64, nb = r % 64;
                    transpose_item(p.in[I_WOUT] + (size_t)l * 2048 * 2048, 2048, 2048, (bf16_t*)(ws + WS_WOUTT) + (size_t)l * 2048 * 2048, kb * 64, nb * 32, nb * 32, scr, lane); } }
        }
    }
}

DI void phaseA(const P& p, LAS unsigned char* lds, int layer) {
    TID_SETUP
    unsigned char* ws = p.ws;
    {
        const u32x4* src = (const u32x4*)((const bf16_t*)(ws + WS_WG) + (size_t)layer * 32768);
        for (int i = tid; i < 4096; i += 512) ((LAS u32x4*)lds)[i] = src[i];
    }
    __syncthreads();
    const float* modl = (const float*)(ws + WS_MOD) + (size_t)layer * 5 * 6144;
    const float* nw = p.in[I_NORMW] + layer * 2048;
    bf16_t* H = (bf16_t*)(ws + WS_H); float* gates = (float*)(ws + WS_GATES);
    const int gw = blockIdx.x * 8 + wave, NGW = gridDim.x * 8;
#define A_LOAD(dst, row) do { const int r_ = (row); \
        if (layer == 0) { const float* xr_ = r_ < 4096 ? p.in[I_XP] + (size_t)r_ * 2048 : p.in[I_XS] + (size_t)(r_ - 4096) * 2048; \
            _Pragma("unroll") for (int j = 0; j < 8; ++j) dst[j] = __builtin_nontemporal_load((const f32x4*)(xr_ + 4 * lane + 256 * j)); } \
        else { const bf16_t* xr_ = (const bf16_t*)(ws + WS_X1B) + (size_t)r_ * 2048; \
            _Pragma("unroll") for (int j = 0; j < 8; ++j) { const u32x2 w_ = *(const u32x2*)(xr_ + 4 * lane + 256 * j); \
                dst[j][0] = __uint_as_float(w_.x << 16); dst[j][1] = __uint_as_float(w_.x & 0xffff0000u); dst[j][2] = __uint_as_float(w_.y << 16); dst[j][3] = __uint_as_float(w_.y & 0xffff0000u); } } } while (0)
    for (int m = gw; m < NTOK; m += NGW) {
        f32x4 xv[8]; A_LOAD(xv, m);
        const int ci = m < 4096 ? 0 : 1 + ((m - 4096) >> 10);
        const float* shp = modl + ci * 6144; const float* scp = shp + 2048;
        float ss = 0.f;
#pragma unroll
        for (int j = 0; j < 8; ++j) ss += (xv[j][0] * xv[j][0] + xv[j][1] * xv[j][1]) + (xv[j][2] * xv[j][2] + xv[j][3] * xv[j][3]);
        const float rstd = rsqrtf(wave_sum(ss) * (1.f / 2048.f) + EPS);
        float ga[16];
#pragma unroll
        for (int n = 0; n < 16; ++n) ga[n] = 0.f;
#pragma unroll
        for (int j = 0; j < 8; ++j) { const int k = 4 * lane + 256 * j;
            const f32x4 w4 = *(const f32x4*)(nw + k), sh = *(const f32x4*)(shp + k), sc = *(const f32x4*)(scp + k);
            f32x4 v = xv[j] * rstd * w4 * (sc + 1.f) + sh;
            u32x2 o; o.x = pk2(v[0], v[1]); o.y = pk2(v[2], v[3]);
            *(u32x2*)(H + (size_t)m * 2048 + k) = o;
#pragma unroll
            for (int n = 0; n < 16; ++n) { const u32x2 w = *(const LAS u32x2*)(lds + (size_t)(n * 2048 + k) * 2);
                ga[n] = dot2bf(o.y, w.y, dot2bf(o.x, w.x, ga[n])); } }
        float mine = 0.f;
#pragma unroll
        for (int n = 0; n < 16; ++n) { const float s = wave_sum(ga[n]); mine = (lane == n) ? s : mine; }
        if (lane < 16) gates[(size_t)m * 16 + lane] = mine + p.in[I_BIF][layer * 16 + lane];
    }
#undef A_LOAD
    __syncthreads();
}

DI void phaseB2(const P& p, LAS unsigned char* lds, int layer) {
    TID_SETUP
    unsigned char* ws = p.ws;
    const bf16_t* Z = (const bf16_t*)(ws + WS_Z);
    LAS float* tile = (LAS float*)lds;
    LAS float* rope = (LAS float*)(lds + 36864);
    for (int i = tid; i < 1024; i += 512) ((LAS f32x4*)rope)[i] = ((const f32x4*)(ws + WS_ROPE))[i];
#define B2_DECODE(ITEM, tt, gi, LAT, b, t0, T, tokbase, kind, hd, zcol) \
        const int tt = (ITEM) / 2, gi = (ITEM) % 2; const bool LAT = tt >= 64; \
        const int b = LAT ? (tt - 64) >> 4 : tt >> 2, t0 = LAT ? ((tt - 64) & 15) * 64 : (tt & 3) * 64, T = LAT ? 1024 : 256; const int tokbase = tt * 64; \
        const int kind = gi < 2 ? 1 : gi < 6 ? 3 : gi < 10 ? 4 : gi < 14 ? 5 : 6; \
        const int hd = gi < 2 ? gi : gi < 6 ? gi - 2 : gi < 10 ? gi - 6 : gi < 14 ? gi - 10 : gi - 14; \
        const int zcol = (kind == 0 ? ZQ : kind == 1 ? ZK : kind == 2 ? ZV : kind == 3 ? ZMQ : kind == 4 ? ZMK : kind == 5 ? ZMV : ZFX) + hd * 128; (void)b; (void)T; (void)t0;
#define B2_LOAD(tokbase, zcol, kind, t0, T) do { \
        pv0 = *(const bf16x8*)(Z + (size_t)((tokbase) + (tid >> 4)) * NZ + (zcol) + (tid & 15) * 8); \
        pv1 = *(const bf16x8*)(Z + (size_t)((tokbase) + 32 + (tid >> 4)) * NZ + (zcol) + (tid & 15) * 8); \
        ph = (bf16x8){0, 0, 0, 0, 0, 0, 0, 0}; \
        if (((kind) == 3 || (kind) == 4) && tid < 32) { const int tl_ = (tid >> 4) ? 64 : -1; if ((t0) + tl_ >= 0 && (t0) + tl_ < (T)) ph = *(const bf16x8*)(Z + (size_t)((tokbase) + tl_) * NZ + (zcol) + (tid & 15) * 8); } } while (0)
    bf16x8 pv0, pv1, ph;
    if ((int)blockIdx.x < 128 * 2) { B2_DECODE((int)blockIdx.x, tt_, gi_, LAT_, b_, t0_, T_, tokbase_, kind_, hd_, zcol_) (void)hd_; B2_LOAD(tokbase_, zcol_, kind_, t0_, T_); }
    for (int item = blockIdx.x; item < 128 * 2; item += gridDim.x) {
        B2_DECODE(item, tt, gi, LAT, b, t0, T, tokbase, kind, hd, zcol)
        {   const int row = tid >> 4, c8 = (tid & 15) * 8;
#pragma unroll
            for (int jj = 0; jj < 8; ++jj) { tile[(row + 1) * 129 + c8 + jj] = bfs2f(pv0[jj]); tile[(row + 33) * 129 + c8 + jj] = bfs2f(pv1[jj]); }
            if ((kind == 3 || kind == 4) && tid < 32) { const int tl = (tid >> 4) ? 64 : -1;
#pragma unroll
                for (int jj = 0; jj < 8; ++jj) tile[(tl + 1) * 129 + c8 + jj] = bfs2f(ph[jj]); } }
        if (item + (int)gridDim.x < 128 * 2) { B2_DECODE(item + (int)gridDim.x, tt_, gi_, LAT_, b_, t0_, T_, tokbase_, kind_, hd_, zcol_) (void)hd_; B2_LOAD(tokbase_, zcol_, kind_, t0_, T_); }
        __syncthreads();
        if (kind <= 1) {
            const float* nwp = (kind == 0 ? p.in[I_QN] : p.in[I_KN]) + layer * 128;
            const int dA = lane < 32 ? lane : lane + 32, dB = dA + 32;
            const float wA = nwp[dA], wB = nwp[dB];
#pragma unroll
            for (int rr = 0; rr < 8; ++rr) { const int row = wave * 8 + rr;
                float xA = tile[(row + 1) * 129 + dA], xB = tile[(row + 1) * 129 + dB];
                const float rstd = rsqrtf(wave_sum(xA * xA + xB * xB) * (1.f / 128.f) + EPS);
                float yA = xA * rstd * wA, yB = xB * rstd * wB;
                if (LAT) { const int pos = lane < 32 ? (t0 >> 6) : row; const float c = rope[2 * (pos * 32 + (lane & 31))], s = rope[2 * (pos * 32 + (lane & 31)) + 1];
                    const float a = yA * c - yB * s, bb = yA * s + yB * c; yA = a; yB = bb; }
                tile[(row + 1) * 129 + dA] = yA; tile[(row + 1) * 129 + dB] = yB; }
            __syncthreads();
        } else if (kind == 3 || kind == 4) {
            const int cc0 = (kind == 3 ? 0 : 512) + hd * 128;
            const float* cw = p.in[I_CONVW] + (size_t)layer * 3 * 1024 + cc0; const float* cb = p.in[I_CONVB] + layer * 1024 + cc0;
            const int c = tid & 127; const float w0 = cw[c], w1 = cw[1024 + c], w2 = cw[2048 + c], bb = cb[c]; const float osc = kind == 4 ? 0.08838834764831845f : 1.f;
            float vals[16];
#pragma unroll
            for (int i = 0; i < 16; ++i) { const int row = (tid >> 7) + 4 * i; const float v = w0 * tile[row * 129 + c] + w1 * tile[(row + 1) * 129 + c] + w2 * tile[(row + 2) * 129 + c] + bb; vals[i] = silu_f(v) * osc; }
            __syncthreads();
#pragma unroll
            for (int i = 0; i < 16; ++i) { const int row = (tid >> 7) + 4 * i; tile[(row + 1) * 129 + c] = vals[i]; }
            __syncthreads();
        }
        if (kind <= 4) {
            bf16_t* dst;
            if (kind == 0) dst = (bf16_t*)(ws + WS_Q) + (LAT ? (size_t)4096 * 1024 : 0) + ((size_t)(b * 8 + hd) * T + t0) * 128;
            else if (kind == 1 || kind == 2) { bf16_t* base = (bf16_t*)(ws + (kind == 1 ? WS_K : WS_V));
                dst = LAT ? base + KC_ELEMS + (size_t)layer * KL_ELEMS + ((size_t)(b * 2 + hd) * 1536 + 512 + t0) * 128 : base + ((size_t)(b * 2 + hd) * 256 + t0) * 128; }
            else dst = (bf16_t*)(ws + (kind == 3 ? WS_MQ : WS_MK)) + (LAT ? (size_t)4096 * 512 : 0) + ((size_t)(b * 4 + hd) * T + t0) * 128;
#pragma unroll
            for (int i = 0; i < 2; ++i) { const int ch = tid + 512 * i, row = ch >> 4, c8 = (ch & 15) * 8; float v[8];
#pragma unroll
                for (int j = 0; j < 8; ++j) v[j] = tile[(row + 1) * 129 + c8 + j];
                *(bf16x8*)(dst + (size_t)row * 128 + c8) = pack8(v); }
        }
        if (kind >= 4) {
            bf16_t* dst = (bf16_t*)(ws + (kind == 4 ? WS_MKT : (kind == 5 ? WS_MVT : WS_XT))) + (LAT ? (size_t)4096 * 512 : 0) + (size_t)(b * 4 + hd) * 128 * T + t0;
#pragma unroll
            for (int i = 0; i < 2; ++i) { const int ch = tid + 512 * i, c = ch & 127, t8 = (ch >> 7) * 8; float v[8];
#pragma unroll
                for (int j = 0; j < 8; ++j) v[j] = tile[(t8 + j + 1) * 129 + c];
                *(bf16x8*)(dst + (size_t)c * T + t8) = pack8(v); }
        }
        if (!LAT && (kind == 1 || kind == 2)) {
            float* o = p.out + (kind == 1 ? O_NK : O_NV);
#pragma unroll
            for (int i = 0; i < 4; ++i) { const int ch = tid + 512 * i, row = ch >> 5, c4 = (ch & 31) * 4;
                f32x4 v; v[0] = tile[(row + 1) * 129 + c4]; v[1] = tile[(row + 1) * 129 + c4 + 1]; v[2] = tile[(row + 1) * 129 + c4 + 2]; v[3] = tile[(row + 1) * 129 + c4 + 3];
                __builtin_nontemporal_store(v, (f32x4*)(o + ((((size_t)b * 2 + layer) * 256 + t0 + row) * 2 + hd) * 128 + c4)); }
        }
        __syncthreads();
    }
}

DI float scan_add(float x, int lane, bool rev) {
#pragma unroll
    for (int o = 1; o < 64; o <<= 1) { const float v = rev ? __shfl_down(x, o) : __shfl_up(x, o); const bool ok = rev ? (lane + o < 64) : (lane >= o); if (ok) x += v; }
    return x;
}
DI float scan_max(float x, int lane, bool rev) {
#pragma unroll
    for (int o = 1; o < 64; o <<= 1) { const float v = rev ? __shfl_down(x, o) : __shfl_up(x, o); const bool ok = rev ? (lane + o < 64) : (lane >= o); if (ok) x = fmaxf(x, v); }
    return x;
}

DI att::s16x4 xtr(int addr) { att::s16x4 r; asm volatile("ds_read_b64_tr_b16 %0, %1" : "=&v"(r) : "v"(addr) : "memory"); return r; }
DI bf16x8 trfrag(int addr) {
    att::s16x4 l, h;
    asm volatile("ds_read_b64_tr_b16 %0, %2\n\tds_read_b64_tr_b16 %1, %2 offset:2048\n\ts_waitcnt lgkmcnt(0)" : "=&v"(l), "=&v"(h) : "v"(addr) : "memory");
    return (bf16x8){l[0], l[1], l[2], l[3], h[0], h[1], h[2], h[3]}; }
DI void trfrag3(bf16x8& f0, bf16x8& f1, bf16x8& f2, int a0, int a1, int a2) {
    att::s16x4 l0, h0, l1, h1, l2, h2;
    asm volatile("ds_read_b64_tr_b16 %0, %6\n\tds_read_b64_tr_b16 %1, %6 offset:2048\n\tds_read_b64_tr_b16 %2, %7\n\tds_read_b64_tr_b16 %3, %7 offset:2048\n\tds_read_b64_tr_b16 %4, %8\n\tds_read_b64_tr_b16 %5, %8 offset:2048\n\ts_waitcnt lgkmcnt(0)"
                 : "=&v"(l0), "=&v"(h0), "=&v"(l1), "=&v"(h1), "=&v"(l2), "=&v"(h2) : "v"(a0), "v"(a1), "v"(a2) : "memory");
    f0 = (bf16x8){l0[0], l0[1], l0[2], l0[3], h0[0], h0[1], h0[2], h0[3]}; f1 = (bf16x8){l1[0], l1[1], l1[2], l1[3], h1[0], h1[1], h1[2], h1[3]}; f2 = (bf16x8){l2[0], l2[1], l2[2], l2[3], h2[0], h2[1], h2[2], h2[3]}; }
DI void trfrag2(bf16x8& f0, bf16x8& f1, int a0, int a1) {
    att::s16x4 l0, h0, l1, h1;
    asm volatile("ds_read_b64_tr_b16 %0, %4\n\tds_read_b64_tr_b16 %1, %4 offset:2048\n\tds_read_b64_tr_b16 %2, %5\n\tds_read_b64_tr_b16 %3, %5 offset:2048\n\ts_waitcnt lgkmcnt(0)"
                 : "=&v"(l0), "=&v"(h0), "=&v"(l1), "=&v"(h1) : "v"(a0), "v"(a1) : "memory");
    f0 = (bf16x8){l0[0], l0[1], l0[2], l0[3], h0[0], h0[1], h0[2], h0[3]}; f1 = (bf16x8){l1[0], l1[1], l1[2], l1[3], h1[0], h1[1], h1[2], h1[3]}; }
struct Conv8 { f32x4 w[3][2]; f32x4 b[2]; };
DI void conv8_load(Conv8& c, const float* cw, const float* cb) {
#pragma unroll
    for (int j = 0; j < 3; ++j) { c.w[j][0] = *(const f32x4*)(cw + j * 1024); c.w[j][1] = *(const f32x4*)(cw + j * 1024 + 4); }
    c.b[0] = *(const f32x4*)cb; c.b[1] = *(const f32x4*)(cb + 4);
}
DI void conv8_apply(float (&o)[8], const Conv8& c, const bf16_t* zrow, bool has_prev, bool has_next, float osc) {
    const bf16x8 z8 = {0, 0, 0, 0, 0, 0, 0, 0};
    const bf16x8 x1 = *(const bf16x8*)zrow; bf16x8 x0 = z8, x2 = z8;
    if (has_prev) x0 = *(const bf16x8*)(zrow - NZ);
    if (has_next) x2 = *(const bf16x8*)(zrow + NZ);
#pragma unroll
    for (int j = 0; j < 8; ++j) { const float v = c.w[0][j >> 2][j & 3] * bfs2f(x0[j]) + c.w[1][j >> 2][j & 3] * bfs2f(x1[j]) + c.w[2][j >> 2][j & 3] * bfs2f(x2[j]) + c.b[j >> 2][j & 3]; o[j] = silu_f(v) * osc; }
}
template <bool LAT>
DI void gate_scan_block(const P& p, LAS unsigned char* lds, int layer, int b, int head, int dir) {
    TID_SETUP
    constexpr int T = LAT ? 1024 : 256, NCH = T / 64;
    unsigned char* ws = p.ws;
    const int tok0 = LAT ? 4096 + b * 1024 : b * 256;
    const int sidx = ((b * 2 + layer) * 2 + dir) * 4 + head;
    const float m0 = LAT ? p.in[I_SM][sidx] : 0.f;
    float* GS = (float*)(ws + WS_GS) + (size_t)(dir * 4 + head) * NTOK;
    float* DEC = (float*)(ws + WS_DEC) + (dir * 4 + head) * 128;
    const float* gates = (const float*)(ws + WS_GATES);
    LAS float* bl_l = (LAS float*)lds; LAS float* am_l = bl_l + 16;
    float a_r[2], bc_r[2], am_r[2];
#pragma unroll
    for (int q = 0; q < 2; ++q) { const int it = wave + 8 * q; a_r[q] = 0.f; bc_r[q] = 0.f; am_r[q] = 0.f;
        if (it < NCH) { const int cj = dir ? NCH - 1 - it : it; const float* gr = gates + (size_t)(tok0 + cj * 64 + lane) * 16;
            const float giv = gr[(dir ? 8 : 0) + head], gfv = gr[(dir ? 12 : 4) + head];
            const float lf = fminf(gfv, 0.f) - log1pf(expf(-fabsf(gfv)));
            const float bc = scan_add(lf, lane, dir != 0); const float a = giv - bc; const float am = scan_max(a, lane, dir != 0);
            const int last = dir ? 0 : 63;
            const float blast = __shfl(bc, last), amall = __shfl(am, last);
            if (lane == 0) { bl_l[it] = blast; am_l[it] = amall; }
            a_r[q] = a; bc_r[q] = bc; am_r[q] = am; } }
    __syncthreads();
#pragma unroll
    for (int q = 0; q < 2; ++q) { const int it = wave + 8 * q;
        if (it < NCH) { const int cj = dir ? NCH - 1 - it : it; const int tok = tok0 + cj * 64 + lane;
            float m = m0; for (int k = 0; k < it; ++k) m = bl_l[k] + fmaxf(m, am_l[k]);
            const float M = fmaxf(m, am_r[q]), Mall = fmaxf(m, am_l[it]);
            GS[tok] = a_r[q]; GS[65536 + tok] = M; GS[2 * 65536 + tok] = expf(m - M); GS[3 * 65536 + tok] = expf(-(bc_r[q] + M)); GS[4 * 65536 + tok] = expf(a_r[q] - Mall);
            if (lane == 0) DEC[(tok0 >> 6) + cj] = expf(m - Mall);
            if (!LAT && it == NCH - 1 && lane == 0) p.out[O_NM + sidx] = bl_l[it] + Mall; } }
    __syncthreads();
}

DI void gate_scan_phase(const P& p, LAS unsigned char* lds, int layer) {
    for (int s = blockIdx.x; s < 160; s += gridDim.x) {
        if (s < 128) gate_scan_block<false>(p, lds, layer, s >> 3, (s >> 1) & 3, s & 1);
        else gate_scan_block<true>(p, lds, layer, (s - 128) >> 3, (s >> 1) & 3, s & 1); }
}

struct M1Rows { bf16x8 v[2], k0[2], k1[2], k2[2]; float w0[2], w1[2]; };
DI void m1_rows_load(M1Rows& R, const bf16_t* Z, const float* WK0, const float* WK1, int t0, int T, int tid) {
    const bf16x8 z8 = {0, 0, 0, 0, 0, 0, 0, 0}; const int c8 = (tid & 15) * 8;
#pragma unroll
    for (int i = 0; i < 2; ++i) { const int row = (tid >> 4) + 32 * i; const bf16_t* zr = Z + (size_t)row * NZ;
        R.v[i] = *(const bf16x8*)(zr + ZMV + c8); R.k1[i] = *(const bf16x8*)(zr + ZMK + c8);
        R.k0[i] = (t0 + row > 0) ? *(const bf16x8*)(zr - NZ + ZMK + c8) : z8; R.k2[i] = (t0 + row < T - 1) ? *(const bf16x8*)(zr + NZ + ZMK + c8) : z8;
        R.w0[i] = WK0[row]; R.w1[i] = WK1[row]; }
}
DI void m1_group(const P& p, LAS unsigned char* lds, int layer, int gidx) {
    TID_SETUP
    unsigned char* ws = p.ws;
    const int id0 = gidx * 4; const bool LAT = id0 >= 256; const int u0 = LAT ? id0 - 256 : id0;
    const int b = LAT ? u0 >> 6 : u0 >> 4, head = LAT ? (u0 >> 4) & 3 : (u0 >> 2) & 3, chunk0 = LAT ? u0 & 15 : u0 & 3;
    const int T = LAT ? 1024 : 256, tok0 = LAT ? 4096 + b * 1024 : b * 256;
    const int c8 = (tid & 15) * 8;
    Conv8 cv; conv8_load(cv, p.in[I_CONVW] + (size_t)layer * 3072 + 512 + head * 128 + c8, p.in[I_CONVB] + layer * 1024 + 512 + head * 128 + c8);
    const bf16_t* Zh = (const bf16_t*)(ws + WS_Z) + (size_t)tok0 * NZ + head * 128;
    const float* WKh = (const float*)(ws + WS_GS) + (size_t)4 * 65536 + (size_t)head * NTOK + tok0;
    const int r = lane & 31, hl = lane >> 5, eb4 = wave >> 1, dh = wave & 1;
    const int vb = (int)(unsigned)(size_t)lds + att::v_rd_base(lane);
    const bf16x8 ones = {0x3F80, 0x3F80, 0x3F80, 0x3F80, 0x3F80, 0x3F80, 0x3F80, 0x3F80};
    M1Rows R; { const int t0 = chunk0 * 64; m1_rows_load(R, Zh + (size_t)t0 * NZ, WKh + t0, WKh + (size_t)4 * NTOK + t0, t0, T, tid); }
#pragma unroll 1
    for (int q = 0; q < 4; ++q) {
        const int t0 = (chunk0 + q) * 64;
#pragma unroll
        for (int i = 0; i < 2; ++i) { const int row = (tid >> 4) + 32 * i; const int st = att::v_st(row, c8);
            *(LAS bf16x8*)(lds + st) = R.v[i];
            float kv[8], k2[8];
#pragma unroll
            for (int e = 0; e < 8; ++e) { const float cvv = cv.w[0][e >> 2][e & 3] * bfs2f(R.k0[i][e]) + cv.w[1][e >> 2][e & 3] * bfs2f(R.k1[i][e]) + cv.w[2][e >> 2][e & 3] * bfs2f(R.k2[i][e]) + cv.b[e >> 2][e & 3];
                const float kk = silu_f(cvv) * 0.08838834764831845f; kv[e] = kk * R.w0[i]; k2[e] = kk * R.w1[i]; }
            *(LAS bf16x8*)(lds + 16384 + st) = pack8(kv); *(LAS bf16x8*)(lds + 32768 + st) = pack8(k2); }
        __syncthreads();
        if (q < 3) { const int t1 = t0 + 64; m1_rows_load(R, Zh + (size_t)t1 * NZ, WKh + t1, WKh + (size_t)4 * NTOK + t1, t1, T, tid); }
#pragma unroll 1
        for (int dir = 0; dir < 2; ++dir) {
            const int kb = vb + 16384 + dir * 16384;
            const int cd = (dir * 4 + head) * 128 + ((tok0 + t0) >> 6);
            f32x16 acc[2], accn[2];
#pragma unroll
            for (int i = 0; i < 16; ++i) { acc[0][i] = 0.f; acc[1][i] = 0.f; accn[0][i] = 0.f; accn[1][i] = 0.f; }
#pragma unroll
            for (int ks = 0; ks < 4; ++ks) {
                bf16x8 vf, kf[2]; trfrag3(vf, kf[0], kf[1], vb + eb4 * 512 + ks * 4096, kb + (2 * dh) * 512 + ks * 4096, kb + (2 * dh + 1) * 512 + ks * 4096);
#pragma unroll
                for (int db = 0; db < 2; ++db) { acc[db] = MFMA32(vf, kf[db], acc[db]);
                    if (eb4 == 0) accn[db] = MFMA32(ones, kf[db], accn[db]); }
            }
            bf16_t* U = (bf16_t*)(ws + WS_U) + (size_t)cd * 16384;
#pragma unroll
            for (int db = 0; db < 2; ++db)
#pragma unroll
                for (int i = 0; i < 16; ++i) U[(32 * eb4 + crow(i, hl)) * 128 + 64 * dh + 32 * db + r] = f2bf(acc[db][i]);
            if (eb4 == 0 && hl == 0) { float* UN = (float*)(ws + WS_UN) + (size_t)cd * 128 + 64 * dh + r; UN[0] = accn[0][0]; UN[32] = accn[1][0]; }
        }
        __syncthreads();
    }
}

template <bool LAT>
DI void m2_unit(const P& p, int layer, int b, int head, int dir, int eg) {
    TID_SETUP
    constexpr int T = LAT ? 1024 : 256, NCH = T / 64;
    unsigned char* ws = p.ws;
    const int tok0 = LAT ? 4096 + b * 1024 : b * 256;
    const int sidx = ((b * 2 + layer) * 2 + dir) * 4 + head;
    const int cdbase = (dir * 4 + head) * 128 + (tok0 >> 6);
    const float* DEC = (const float*)(ws + WS_DEC);
    const int ebase = eg * 2048 + tid;
    float uv[NCH][4], dec[NCH], un[NCH];
#pragma unroll
    for (int it = 0; it < NCH; ++it) { const int cd = cdbase + (dir ? NCH - 1 - it : it); const bf16_t* U = (const bf16_t*)(ws + WS_U) + (size_t)cd * 16384 + ebase;
        dec[it] = DEC[cd];
#pragma unroll
        for (int i = 0; i < 4; ++i) uv[it][i] = bf2f(U[512 * i]);
        un[it] = (eg == 0 && tid < 128) ? ((const float*)(ws + WS_UN))[(size_t)cd * 128 + tid] : 0.f; }
    float C[4];
#pragma unroll
    for (int i = 0; i < 4; ++i) { const int idx = ebase + 512 * i, e = idx >> 7, d = idx & 127; C[i] = LAT ? p.in[I_SC][(size_t)sidx * 16384 + d * 128 + e] : 0.f; }
    float n = 0.f; if (LAT && eg == 0 && tid < 128) n = p.in[I_SN][sidx * 128 + tid];
#pragma unroll
    for (int it = 0; it < NCH; ++it) { const int cd = cdbase + (dir ? NCH - 1 - it : it);
        bf16_t* CJ = (bf16_t*)(ws + WS_CJ) + (size_t)cd * 16384 + ebase;
#pragma unroll
        for (int i = 0; i < 4; ++i) { CJ[512 * i] = f2bf(C[i]); C[i] = dec[it] * C[i] + uv[it][i]; }
        if (eg == 0 && tid < 128) { ((float*)(ws + WS_NJ))[(size_t)cd * 128 + tid] = n; n = dec[it] * n + un[it]; } }
    if (!LAT) {
#pragma unroll
        for (int i = 0; i < 4; ++i) { const int idx = ebase + 512 * i, e = idx >> 7, d = idx & 127; p.out[O_NC + (size_t)sidx * 16384 + d * 128 + e] = C[i]; }
        if (eg == 0 && tid < 128) p.out[O_NN + (size_t)sidx * 128 + tid] = n;
    }
}

template <bool LAT> struct M2Regs { bf16x8 uv[(LAT ? 16 : 4)]; float dec[(LAT ? 16 : 4)]; float un[(LAT ? 16 : 4)]; };
template <bool LAT>
DI void m2_load(const P& p, M2Regs<LAT>& R, int b, int head, int dir, int eg, int tid) {
    constexpr int NCH = LAT ? 16 : 4;
    unsigned char* ws = p.ws;
    const int tok0 = LAT ? 4096 + b * 1024 : b * 256;
    const int cdbase = (dir * 4 + head) * 128 + (tok0 >> 6);
    const int ebase = eg * 4096 + tid * 8;
#pragma unroll
    for (int it = 0; it < NCH; ++it) { const int cd = cdbase + (dir ? NCH - 1 - it : it);
        R.dec[it] = ((const float*)(ws + WS_DEC))[cd];
        R.uv[it] = __builtin_nontemporal_load((const bf16x8*)((const bf16_t*)(ws + WS_U) + (size_t)cd * 16384 + ebase));
        R.un[it] = (eg == 0 && tid < 128) ? ((const float*)(ws + WS_UN))[(size_t)cd * 128 + tid] : 0.f; }
}
template <bool LAT>
DI void m2_run(const P& p, const M2Regs<LAT>& R, int layer, int b, int head, int dir, int eg, int tid) {
    constexpr int NCH = LAT ? 16 : 4;
    unsigned char* ws = p.ws;
    const int tok0 = LAT ? 4096 + b * 1024 : b * 256;
    const int sidx = ((b * 2 + layer) * 2 + dir) * 4 + head;
    const int cdbase = (dir * 4 + head) * 128 + (tok0 >> 6);
    const int ebase = eg * 4096 + tid * 8, e = ebase >> 7, d0 = ebase & 127;
    float C[8];
#pragma unroll
    for (int i = 0; i < 8; ++i) C[i] = LAT ? p.in[I_SC][(size_t)sidx * 16384 + (d0 + i) * 128 + e] : 0.f;
    float n = 0.f; if (LAT && eg == 0 && tid < 128) n = p.in[I_SN][sidx * 128 + tid];
#pragma unroll
    for (int it = 0; it < NCH; ++it) { const int cd = cdbase + (dir ? NCH - 1 - it : it);
        *(bf16x8*)((bf16_t*)(ws + WS_CJ) + (size_t)cd * 16384 + ebase) = pack8(C);
#pragma unroll
        for (int i = 0; i < 8; ++i) C[i] = R.dec[it] * C[i] + bfs2f(R.uv[it][i]);
        if (eg == 0 && tid < 128) { ((float*)(ws + WS_NJ))[(size_t)cd * 128 + tid] = n; n = R.dec[it] * n + R.un[it]; } }
    if (!LAT) {
#pragma unroll
        for (int i = 0; i < 8; ++i) __builtin_nontemporal_store(C[i], &p.out[O_NC + (size_t)sidx * 16384 + (d0 + i) * 128 + e]);
        if (eg == 0 && tid < 128) p.out[O_NN + (size_t)sidx * 128 + tid] = n;
    }
}
DI void m2_block(const P& p, int layer, int slot) {
    TID_SETUP
    M2Regs<false> Rc[2]; M2Regs<true> Rl;
#pragma unroll
    for (int k = 0; k < 2; ++k) { const int u = slot + 256 * k, s = u >> 2; m2_load<false>(p, Rc[k], s >> 3, (s >> 1) & 3, s & 1, u & 3, tid); }
    if (slot < 128) { const int s = slot >> 2; m2_load<true>(p, Rl, s >> 3, (s >> 1) & 3, s & 1, slot & 3, tid); }
#pragma unroll
    for (int k = 0; k < 2; ++k) { const int u = slot + 256 * k, s = u >> 2; m2_run<false>(p, Rc[k], layer, s >> 3, (s >> 1) & 3, s & 1, u & 3, tid); }
    if (slot < 128) { const int s = slot >> 2; m2_run<true>(p, Rl, layer, s >> 3, (s >> 1) & 3, s & 1, slot & 3, tid); }
}

DI void m3_task(const P& p, LAS unsigned char* lds, int layer, int id) {
    TID_SETUP
    unsigned char* ws = p.ws;
    const bool LAT = id >= 256; const int u = LAT ? id - 256 : id;
    const int b = LAT ? u >> 6 : u >> 4, head = LAT ? (u >> 4) & 3 : (u >> 2) & 3, chunk = LAT ? u & 15 : u & 3;
    const int T = LAT ? 1024 : 256, tok0 = LAT ? 4096 + b * 1024 : b * 256, t0 = chunk * 64;
    const int dir = wave >> 2, w4 = wave & 3, td = tid & 255;
    const int cd = (dir * 4 + head) * 128 + ((tok0 + t0) >> 6);
    const float* GS = (const float*)(ws + WS_GS) + (size_t)(dir * 4 + head) * NTOK + tok0 + t0;
    LAS bf16_t* Ql = (LAS bf16_t*)(lds + 98304); LAS bf16_t* Kl = (LAS bf16_t*)(lds + 98304 + 17408); LAS unsigned char* Vimg = lds + 98304 + 34816;
    {   const bf16_t* Zc = (const bf16_t*)(ws + WS_Z) + (size_t)(tok0 + t0) * NZ + head * 128; const int c8 = (tid & 15) * 8;
        Conv8 cq, ck; conv8_load(cq, p.in[I_CONVW] + (size_t)layer * 3072 + head * 128 + c8, p.in[I_CONVB] + layer * 1024 + head * 128 + c8);
        conv8_load(ck, p.in[I_CONVW] + (size_t)layer * 3072 + 512 + head * 128 + c8, p.in[I_CONVB] + layer * 1024 + 512 + head * 128 + c8);
#pragma unroll
        for (int i = 0; i < 2; ++i) { const int row = (tid >> 4) + 32 * i; const bool hp = t0 + row > 0, hn = t0 + row < T - 1; float v8[8];
            conv8_apply(v8, cq, Zc + (size_t)row * NZ + ZMQ + c8, hp, hn, 1.f); *(LAS bf16x8*)(Ql + row * 136 + c8) = pack8(v8);
            conv8_apply(v8, ck, Zc + (size_t)row * NZ + ZMK + c8, hp, hn, 0.08838834764831845f); *(LAS bf16x8*)(Kl + row * 136 + c8) = pack8(v8);
            *(LAS bf16x8*)(Vimg + att::v_st(row, c8)) = __builtin_nontemporal_load((const bf16x8*)(Zc + (size_t)row * NZ + ZMV + c8)); } }
    LAS unsigned char* L = lds + dir * 49152;
    LAS bf16_t* CTl = (LAS bf16_t*)L; LAS bf16_t* Sl = (LAS bf16_t*)(L + 34816); LAS float* vec = (LAS float*)(L + 44032);
    LAS float* Hl = (LAS float*)L;
    LAS float *a_l = vec, *M_l = vec + 64, *wi_l = vec + 128, *emr_l = vec + 192, *dinv_l = vec + 320, *qn_l = vec + 384, *n_l = vec + 640;
    const int r = lane & 31, hl = lane >> 5, wi = w4 >> 1, wj = w4 & 1;
    if (td < 64) { a_l[td] = GS[td]; M_l[td] = GS[65536 + td]; wi_l[td] = GS[2 * 65536 + td]; emr_l[td] = GS[3 * 65536 + td]; }
    if (td >= 128) n_l[td - 128] = ((const float*)(ws + WS_NJ))[(size_t)cd * 128 + td - 128];
    {   const bf16_t* CJ = (const bf16_t*)(ws + WS_CJ) + (size_t)cd * 16384;
#pragma unroll
        for (int i = 0; i < 8; ++i) { const int ch = td + 256 * i, e = ch >> 4, d8 = (ch & 15) * 8; *(LAS bf16x8*)(CTl + e * 136 + d8) = __builtin_nontemporal_load((const bf16x8*)(CJ + e * 128 + d8)); } }
    __syncthreads();
    bf16x8 qf[8];
#pragma unroll
    for (int ks = 0; ks < 8; ++ks) qf[ks] = *(const LAS bf16x8*)(Ql + (32 * wi + r) * 136 + 16 * ks + 8 * hl);
    {   const int pp = td & 63, part = td >> 6; const LAS bf16_t* qp = Ql + pp * 136 + 32 * part; float s = 0.f;
#pragma unroll
        for (int c = 0; c < 4; ++c) { const bf16x8 v = *(const LAS bf16x8*)(qp + 8 * c);
#pragma unroll
            for (int j = 0; j < 8; ++j) s += bfs2f(v[j]) * n_l[32 * part + 8 * c + j]; }
        qn_l[part * 64 + pp] = s; }
    {   f32x16 sacc;
#pragma unroll
        for (int i = 0; i < 16; ++i) sacc[i] = 0.f;
#pragma unroll
        for (int ks = 0; ks < 8; ++ks) { const bf16x8 kf = *(const LAS bf16x8*)(Kl + (32 * wj + r) * 136 + 16 * ks + 8 * hl); sacc = MFMA32(qf[ks], kf, sacc); }
        const int s_ = 32 * wj + r; const float as = a_l[s_];
#pragma unroll
        for (int i = 0; i < 16; ++i) { const int pr = 32 * wi + crow(i, hl); const bool valid = dir ? (s_ >= pr) : (s_ <= pr);
            const float v = valid ? sacc[i] * __expf(as - M_l[pr]) : 0.f;
            Sl[pr * 72 + s_] = f2bf(v); } }
    __syncthreads();
    if (w4 == 0) { float rs = 0.f;
#pragma unroll
        for (int c = 0; c < 8; ++c) { const bf16x8 v = *(const LAS bf16x8*)(Sl + lane * 72 + 8 * c);
#pragma unroll
            for (int j = 0; j < 8; ++j) rs += bfs2f(v[j]); }
        const float qn = (qn_l[lane] + qn_l[64 + lane]) + (qn_l[128 + lane] + qn_l[192 + lane]);
        const float den = wi_l[lane] * qn + rs; dinv_l[lane] = 1.f / fmaxf(fabsf(den), emr_l[lane]); }
    f32x16 nacc[2];
#pragma unroll
    for (int i = 0; i < 16; ++i) { nacc[0][i] = 0.f; nacc[1][i] = 0.f; }
#pragma unroll
    for (int ks = 0; ks < 8; ++ks)
#pragma unroll
        for (int eb = 0; eb < 2; ++eb) { const bf16x8 cf = *(const LAS bf16x8*)(CTl + (64 * wj + 32 * eb + r) * 136 + 16 * ks + 8 * hl); nacc[eb] = MFMA32(qf[ks], cf, nacc[eb]); }
#pragma unroll
    for (int i = 0; i < 16; ++i) { const float w = wi_l[32 * wi + crow(i, hl)]; nacc[0][i] *= w; nacc[1][i] *= w; }
#pragma unroll
    for (int ks = 0; ks < 4; ++ks) { const bf16x8 sf = *(const LAS bf16x8*)(Sl + (32 * wi + r) * 72 + 16 * ks + 8 * hl);
        bf16x8 vf[2]; { const int va = (int)(unsigned)(size_t)Vimg + att::v_rd_base(lane) + (2 * wj) * 512 + ks * 4096; trfrag2(vf[0], vf[1], va, va + 512); }
#pragma unroll
        for (int eb = 0; eb < 2; ++eb) nacc[eb] = MFMA32(sf, vf[eb], nacc[eb]); }
    __syncthreads();
#pragma unroll
    for (int i = 0; i < 16; ++i) { const int pr = 32 * wi + crow(i, hl); const float di = dinv_l[pr];
        Hl[pr * 132 + 64 * wj + r] = nacc[0][i] * di; Hl[pr * 132 + 64 * wj + 32 + r] = nacc[1][i] * di; }
    __syncthreads();
    {   const bf16_t* Z = (const bf16_t*)(ws + WS_Z); bf16_t* mix = (bf16_t*)(ws + WS_H);
        const float* mln = p.in[I_MLN] + layer * 512 + head * 128; const float wa = mln[lane], wb = mln[lane + 64];
        LAS float* H0 = (LAS float*)lds; LAS float* H1 = (LAS float*)(lds + 49152);
        float xa[8], xb[8], moa[8], mob[8], mga[8], mgb[8];
#pragma unroll
        for (int rr = 0; rr < 8; ++rr) { const int pr = wave * 8 + rr, tok = tok0 + t0 + pr;
            xa[rr] = H0[pr * 132 + lane] + H1[pr * 132 + lane]; xb[rr] = H0[pr * 132 + 64 + lane] + H1[pr * 132 + 64 + lane];
            const bf16_t* zr = Z + (size_t)tok * NZ + head * 128;
            moa[rr] = bf2f(zr[ZMO + lane]); mob[rr] = bf2f(zr[ZMO + lane + 64]); mga[rr] = bf2f(zr[ZMG + lane]); mgb[rr] = bf2f(zr[ZMG + lane + 64]); }
#pragma unroll
        for (int rr = 0; rr < 8; ++rr) { const int pr = wave * 8 + rr, tok = tok0 + t0 + pr;
            const float rstd = rsqrtf(wave_sum(xa[rr] * xa[rr] + xb[rr] * xb[rr]) * (1.f / 128.f) + EPS);
            bf16_t* mr = mix + (size_t)tok * 2048 + 1024 + head * 128;
            mr[lane] = f2bf(xa[rr] * rstd * wa * sigm_f(moa[rr]) * silu_f(mga[rr])); mr[lane + 64] = f2bf(xb[rr] * rstd * wb * sigm_f(mob[rr]) * silu_f(mgb[rr])); }
    }
    __syncthreads();
}

DI void tile_ld(bf16x8 (&rg)[2], const bf16_t* src, int ld, int tid) {
#pragma unroll
    for (int i = 0; i < 2; ++i) { const int ch = tid + 512 * i, row = ch >> 3, c8 = (ch & 7) * 8; rg[i] = *(const bf16x8*)(src + (size_t)row * ld + c8); }
}
DI void tile_st(LAS bf16_t* dst, const bf16x8 (&rg)[2], int tid) {
#pragma unroll
    for (int i = 0; i < 2; ++i) { const int ch = tid + 512 * i, row = ch >> 3, c8 = (ch & 7) * 8; *(LAS bf16x8*)(dst + row * 72 + c8) = rg[i]; }
}

template <bool LAT>
DI void fourier_task(const P& p, LAS unsigned char* lds, int layer, int b, int g, int tile) {
    TID_SETUP
    constexpr int T = LAT ? 1024 : 256, NKT = T / 64;
    unsigned char* ws = p.ws;
    const bf16_t* DC = (const bf16_t*)(ws + (LAT ? WS_DFTL : WS_DFTC)) + (size_t)tile * 128 * T; const bf16_t* DS = DC + (size_t)T * T;
    const bf16_t* XZ = (const bf16_t*)(ws + WS_Z) + (size_t)(LAT ? 4096 + b * 1024 : b * 256) * NZ + ZFX + g * 128;
    const int wr = wave >> 1, wc = wave & 1, r = lane & 31, hl = lane >> 5;
    const int xs0 = att::v_st(tid >> 4, (tid & 15) * 8), xs1 = att::v_st(32 + (tid >> 4), (tid & 15) * 8);
    const size_t xg0 = (size_t)(tid >> 4) * NZ + (tid & 15) * 8;
    f32x16 aP[2], aQ[2];
#pragma unroll
    for (int i = 0; i < 16; ++i) { aP[0][i] = 0.f; aP[1][i] = 0.f; aQ[0][i] = 0.f; aQ[1][i] = 0.f; }
    const bf16_t* CS = (const bf16_t*)(ws + WS_CSW) + (size_t)(layer * 4 + g) * 128 * 256;
    bf16x8 csr[8];
#pragma unroll
    for (int i = 0; i < 8; ++i) { const int ch = tid + 512 * i; csr[i] = *(const bf16x8*)(CS + (size_t)(ch >> 5) * 256 + (ch & 31) * 8); }
    bf16x8 rcA[2], rsA[2], rxA[2], rcB[2], rsB[2], rxB[2];
#define F_LD(S, kt_) do { tile_ld(rc##S, DC + (kt_) * 64, T, tid); tile_ld(rs##S, DS + (kt_) * 64, T, tid); \
        rx##S[0] = __builtin_nontemporal_load((const bf16x8*)(XZ + (size_t)(kt_) * 64 * NZ + xg0)); rx##S[1] = __builtin_nontemporal_load((const bf16x8*)(XZ + (size_t)((kt_) * 64 + 32) * NZ + xg0)); } while (0)
#define F_ST(S, buf_) do { LAS unsigned char* nb_ = lds + (buf_) * 55296; tile_st((LAS bf16_t*)nb_, rc##S, tid); tile_st((LAS bf16_t*)(nb_ + 18432), rs##S, tid); *(LAS bf16x8*)(nb_ + 36864 + xs0) = rx##S[0]; *(LAS bf16x8*)(nb_ + 36864 + xs1) = rx##S[1]; } while (0)
#define F_MMA(buf_) do { LAS unsigned char* cur = lds + (buf_) * 55296; \
        const LAS bf16_t* lc = (const LAS bf16_t*)cur + (32 * wr + r) * 72 + 8 * hl; const LAS bf16_t* ls = lc + 9216; \
        const int xb_ = (int)(unsigned)(size_t)(cur + 36864) + xrd; \
        _Pragma("unroll") for (int ks = 0; ks < 4; ++ks) { \
            const bf16x8 fc = *(const LAS bf16x8*)(lc + 16 * ks), fs = *(const LAS bf16x8*)(ls + 16 * ks); \
            bf16x8 x0, x1; trfrag2(x0, x1, xb_ + ks * 4096, xb_ + 512 + ks * 4096); \
            aP[0] = MFMA32(fc, x0, aP[0]); aP[1] = MFMA32(fc, x1, aP[1]); aQ[0] = MFMA32(fs, x0, aQ[0]); aQ[1] = MFMA32(fs, x1, aQ[1]); } } while (0)
    const int xrd = att::v_rd_base(lane) + wc * 1024;
    F_LD(B, 0); F_ST(B, 0); F_LD(A, 1); __syncthreads();
#pragma unroll 1
    for (int kt = 0; kt < NKT; kt += 2) {
        if (kt + 2 < NKT) F_LD(B, kt + 2);
        F_MMA(0);
        F_ST(A, 1);
        __syncthreads();
        if (kt + 3 < NKT) F_LD(A, kt + 3);
        F_MMA(1);
        if (kt + 2 < NKT) F_ST(B, 0);
        __syncthreads();
    }
#undef F_LD
#undef F_ST
#undef F_MMA
    LAS bf16_t* PQ = (LAS bf16_t*)lds;
#pragma unroll
    for (int cb = 0; cb < 2; ++cb)
#pragma unroll
        for (int i = 0; i < 16; ++i) { const int row = 32 * wr + crow(i, hl);
            PQ[row * 264 + 64 * wc + 32 * cb + r] = f2bf(aP[cb][i]); PQ[row * 264 + 128 + 64 * wc + 32 * cb + r] = f2bf(aQ[cb][i]); }
    LAS bf16_t* CSl = (LAS bf16_t*)(lds + 67584);
#pragma unroll
    for (int i = 0; i < 8; ++i) { const int ch = tid + 512 * i; *(LAS bf16x8*)(CSl + (ch >> 5) * 264 + (ch & 31) * 8) = csr[i]; }
    __syncthreads();
    f32x16 o[2];
#pragma unroll
    for (int i = 0; i < 16; ++i) { o[0][i] = 0.f; o[1][i] = 0.f; }
#pragma unroll
    for (int ks = 0; ks < 16; ++ks) { const bf16x8 af = *(const LAS bf16x8*)(PQ + (32 * wr + r) * 264 + 16 * ks + 8 * hl);
#pragma unroll
        for (int db = 0; db < 2; ++db) { const bf16x8 bfr = *(const LAS bf16x8*)(CSl + (64 * wc + 32 * db + r) * 264 + 16 * ks + 8 * hl); o[db] = MFMA32(af, bfr, o[db]); } }
    const bf16_t* Z = (const bf16_t*)(ws + WS_Z); bf16_t* mix = (bf16_t*)(ws + WS_H);
    const int tokb = (LAT ? 4096 + b * 1024 : b * 256) + tile * 128 + 32 * wr;
#pragma unroll
    for (int i = 0; i < 16; ++i) { const int tok = tokb + crow(i, hl);
#pragma unroll
        for (int db = 0; db < 2; ++db) { const int d = 64 * wc + 32 * db + r; const float fg = bf2f(Z[(size_t)tok * NZ + ZFG + g * 128 + d]);
            mix[(size_t)tok * 2048 + 1536 + g * 128 + d] = f2bf(o[db][i] * silu_f(fg)); } }
    __syncthreads();
}

DI void attn_task(const P& p, unsigned char* lds_generic, int layer, bool LAT, int b, int h, int qb) {
    unsigned char* ws = p.ws;
    const int kvh = h >> 2;
    const int tok0 = LAT ? 4096 + b * 1024 : b * 256, tok = tok0 + qb * 256;
    const bf16_t* Z = (const bf16_t*)(ws + WS_Z);
    const bf16_t* Q = Z + (size_t)tok * NZ + ZQ + h * 128;
    const size_t koff = LAT ? (size_t)KC_ELEMS + (size_t)layer * KL_ELEMS + (size_t)(b * 2 + kvh) * 1536 * 128 : (size_t)(b * 2 + kvh) * 256 * 128;
    const bf16_t* K = (const bf16_t*)(ws + WS_K) + koff; const bf16_t* Vc = (const bf16_t*)(ws + WS_V) + koff;
    const bf16_t* Vz = Z + (size_t)tok0 * NZ + ZV + kvh * 128;
    bf16_t* mix = (bf16_t*)(ws + WS_H) + (size_t)tok * 2048 + h * 128;
    const bf16_t* ag = Z + (size_t)tok * NZ + ZAG + h * 128;
    att::attn_dense_body(Q, K, Vc, Vz, LAT ? 512 : 0, p.in[I_QN] + layer * 128, (const float*)(ws + WS_ROPE), qb * 256, LAT, mix, ag, LAT ? 1536 : 256, (char*)lds_generic);
    __syncthreads();
}

DI void phaseC(const P& p, LAS unsigned char* lds, unsigned char* lds_generic, int layer, int ctr_idx, int types) {
    TID_SETUP
    unsigned* ctr = (unsigned*)(p.ws + WS_CTL) + ctr_idx;
    LAS unsigned* slot = (LAS unsigned*)(lds + LDS_MISC);
    for (;;) {
        if (tid == 0) *slot = atomicAdd(ctr, 1u);
        __syncthreads();
        const int id = __builtin_amdgcn_readfirstlane((int)*slot);
        __syncthreads();
        if (id >= 640) break;
        { const int ty = id < 128 ? 1 : id < 256 ? 4 : id < 384 ? 2 : id < 512 ? 8 : 16; if (!(types & ty)) continue; }
        if (id < 128 || id >= 512) { const bool la = id < 128; const int u = la ? id : id - 512; attn_task(p, lds_generic, layer, la, la ? u >> 5 : u >> 3, la ? (u >> 2) & 7 : u & 7, la ? u & 3 : 0); }
        else if (id >= 256 && id < 384) { m1_group(p, lds, layer, id - 256); }
        else if (id < 256) { const int u = id - 128; fourier_task<true>(p, lds, layer, u >> 5, (u >> 3) & 3, u & 7); }
        else if (id < 512) { const int u = id - 384; fourier_task<false>(p, lds, layer, u >> 3, (u >> 1) & 3, u & 1); }
    }
}

__global__ void __launch_bounds__(512, 2) mega_fwd(P p) {
    extern __shared__ __attribute__((aligned(16))) unsigned char lds_raw[];
    LAS unsigned char* lds = (LAS unsigned char*)lds_raw;
    cg::grid_group grid = cg::this_grid();
    if (threadIdx.x < 4) ((LAS unsigned*)(lds + LDS_MISC))[4 + threadIdx.x] = 0u;
    __syncthreads();
    XcdBarrier xbar = xcd_barrier_post((unsigned*)(p.ws + WS_BAR), (volatile LAS unsigned*)(lds + LDS_MISC) + 4);
    (void)xbar;
#define GSYNC() do { XcdBarrier xb_; xb_.bar = (unsigned*)(p.ws + WS_BAR); xb_.x = xb_xcc_id(); xb_.st = (volatile LAS unsigned*)(lds + LDS_MISC) + 4; xcd_barrier(xb_); } while (0)
    unsigned char* ws = p.ws;
#ifndef DUPMASK
#define DUPMASK 0
#endif
#ifndef DUPC_TYPES
#define DUPC_TYPES 31
#endif
    phase0(p, lds, 0);
    if (p.ws == nullptr) grid.sync();
    GSYNC();
    if (DUPMASK & 1) { phase0(p, lds, 512); GSYNC(); }
    if (DUPMASK & 128) { for (int q = 0; q < 10; ++q) GSYNC(); }
#pragma unroll 1
    for (int layer = 0; layer < 2; ++layer) {
#pragma unroll 1
        for (int rp = 0; rp < ((DUPMASK & 2) ? 2 : 1); ++rp) { phaseA(p, lds, layer); GSYNC(); }
#pragma unroll 1
        for (int rp = 0; rp < ((DUPMASK & 4) ? 2 : 1); ++rp) {
            pg8::Gemm g{(const pg8::bf16_t*)(ws + WS_H), (const pg8::bf16_t*)(ws + WS_WINT) + (size_t)layer * 6144 * 2048, NTOK, NZ, DM};
            pg8::StaticOrder S; S.init(NTOK, NZ, (int)gridDim.x, (int)blockIdx.x);
            pg8::EpiZ E{(pg8::bf16_t*)(ws + WS_Z), NZ, p.out + O_NV + (size_t)layer * 65536};
            pg8::gemm_phase<pg8::EpiZ, pg8::StaticOrder, true, true>(lds, g, S, E);
            GSYNC(); }
#pragma unroll 1
        for (int rp = 0; rp < ((DUPMASK & 8) ? 2 : 1); ++rp) { phaseB2(p, lds, layer); gate_scan_phase(p, lds, layer); GSYNC(); }
#pragma unroll 1
        for (int rp = 0; rp < ((DUPMASK & 16) ? 2 : 1); ++rp) { phaseC(p, lds, lds_raw, layer, 64 * (1 + layer + 2 * rp), rp ? DUPC_TYPES : 31); GSYNC(); }
#pragma unroll 1
        for (int rp = 0; rp < ((DUPMASK & 32) ? 2 : 1); ++rp) {
            for (int slot = blockIdx.x; slot < 256; slot += gridDim.x) m2_block(p, layer, slot);
            GSYNC();
            for (int s = blockIdx.x; s < 512; s += gridDim.x) m3_task(p, lds, layer, s);
            GSYNC(); }
#pragma unroll 1
        for (int rp = 0; rp < ((DUPMASK & 64) ? 2 : 1); ++rp) {
            pg8::Gemm g{(const pg8::bf16_t*)(ws + WS_H), (const pg8::bf16_t*)(ws + WS_WOUTT) + (size_t)layer * 2048 * 2048, NTOK, DM, DM};
            pg8::StaticOrder S; S.init(NTOK, DM, (int)gridDim.x, (int)blockIdx.x);
            const float* modl = (const float*)(ws + WS_MOD) + (size_t)layer * 5 * 6144;
            if (layer == 0) { pg8::EpiRes<false> E{p.in[I_XP], p.in[I_XS], nullptr, (pg8::bf16_t*)(ws + WS_X1B), nullptr, modl}; pg8::gemm_phase<pg8::EpiRes<false>, pg8::StaticOrder, false, true>(lds, g, S, E); }
            else { pg8::EpiRes<true> E{nullptr, nullptr, (const pg8::bf16_t*)(ws + WS_X1B), nullptr, p.out, modl}; pg8::gemm_phase<pg8::EpiRes<true>, pg8::StaticOrder, false, true>(lds, g, S, E); }
            if (layer == 0 || rp + 1 < ((DUPMASK & 64) ? 2 : 1)) GSYNC(); }
    }
}

extern "C" void kernel_launch(void* const* d_in, const int* in_sizes, int n_in, void* d_out, int out_size, void* d_ws, size_t ws_size, hipStream_t stream) {
    static int grid = 0;
    if (grid == 0) {
        if (n_in != 21 || (size_t)out_size != O_END || ws_size < WS_END) { fprintf(stderr, "kernel_launch: unexpected shapes: n_in %d out %d ws %zu (need %zu)\n", n_in, out_size, ws_size, (size_t)WS_END); grid = -1; return; }
        int dev = 0, cus = 0, per_cu = 0;
        hipGetDevice(&dev); hipDeviceGetAttribute(&cus, hipDeviceAttributeMultiprocessorCount, dev);
        if (hipFuncSetAttribute((const void*)mega_fwd, hipFuncAttributeMaxDynamicSharedMemorySize, LDS_BYTES) != hipSuccess) { fprintf(stderr, "kernel_launch: hipFuncSetAttribute failed\n"); grid = -1; return; }
        hipOccupancyMaxActiveBlocksPerMultiprocessor(&per_cu, (const void*)mega_fwd, 512, LDS_BYTES);
        if (per_cu < 1) { fprintf(stderr, "kernel_launch: occupancy query says %d blocks per CU\n", per_cu); per_cu = 1; }
        (void)hipGetLastError();
        grid = cus;
    }
    if (grid < 0) return;
    hipMemsetAsync((char*)d_ws + WS_CTL, 0, 32768, stream);
    P p{};
    for (int i = 0; i < 21; ++i) p.in[i] = (const float*)d_in[i];
    p.out = (float*)d_out; p.ws = (unsigned char*)d_ws;
    void* args[] = {&p};
    hipError_t e = hipLaunchCooperativeKernel((const void*)mega_fwd, dim3(grid), dim3(512), args, LDS_BYTES, stream);
    if (e != hipSuccess) fprintf(stderr, "kernel_launch: cooperative launch failed: %s (grid %d)\n", hipGetErrorString(e), grid);
}
```

```cpp
#include <hip/hip_runtime.h>
#include <hip/hip_cooperative_groups.h>
#include <cstdio>
#include <cstdint>
namespace cg = cooperative_groups;

namespace pg8 {
#define PG8_LAS __attribute__((address_space(3)))
typedef unsigned short bf16_t;
typedef short bf16x8 __attribute__((ext_vector_type(8)));
typedef float f32x4 __attribute__((ext_vector_type(4)));
typedef unsigned u32x4 __attribute__((ext_vector_type(4)));
constexpr int BM = 256, BK = 64, HALF = 128, HTB = HALF * BK * 2  , STAGE_BYTES = 8 * HTB, NXCD = 8, WGM = 8;

__host__ __device__ __forceinline__ int lds_byte(int r, int c) { const int st = (r >> 4) * 2 + (c >> 5), rr = r & 15, cc = c & 31, ob = rr * 64 + cc * 2; return st * 1024 + (ob ^ (((ob >> 9) & 1) << 5)); }
__host__ __device__ __forceinline__ void stage_rc(int b, int& R, int& C) { const int st = b / 1024, sb = b % 1024, swz = sb ^ (((sb >> 9) & 1) << 5); R = (st >> 1) * 16 + swz / 64; C = (st & 1) * 32 + (swz % 64) / 2; }
__host__ __device__ __forceinline__ int perm32(int rho) { const int n = rho >> 4, i = rho & 15; return 8 * (i >> 2) + 4 * n + (i & 3); }

struct Unit { int pm, pn; };
struct Gemm { const bf16_t* A; const bf16_t* Bt; int M, N, K; };

struct StaticOrder {
    int nM, nN, nwg, G, c;
    __host__ __device__ void init(int M, int N, int G_, int c_) { nM = M / BM; nN = N / BM; nwg = nM * nN; G = G_; c = c_; }
    __host__ __device__ bool next(int i, Unit& u) const {
        const long L = (long)i * G + c; if (L >= nwg) return false;
        int wgid = (int)L; { const int q = nwg / NXCD, r = nwg % NXCD, xcd = wgid % NXCD, off = wgid / NXCD; wgid = (xcd < r ? xcd * (q + 1) : r * (q + 1) + (xcd - r) * q) + off; }
        const int nig = WGM * nN, gid = wgid / nig, fm = gid * WGM, gsz = (nM - fm) < WGM ? (nM - fm) : WGM;
        u.pm = fm + ((wgid % nig) % gsz); u.pn = (wgid % nig) / gsz; return true;
    }
    __device__ __forceinline__ void a_ready(const Unit&) const {}
    __device__ __forceinline__ void done(const Unit&) const {}
};
__device__ __forceinline__ unsigned cvt_pk_bf16(float lo, float hi) { unsigned r; asm volatile("v_cvt_pk_bf16_f32 %0, %1, %2" : "=v"(r) : "v"(lo), "v"(hi)); return r; }

struct EpiZ {
    static constexpr bool PERM = true, AFTER_DRAIN = false;
    bf16_t* O; int ldc; float* nv;
    __device__ __forceinline__ void operator()(const f32x4 (&acc)[2][2][4][2], const Unit& u, int wr, int wc, int fr, int fq) const {
        const int row0 = u.pm * BM + wr * 64 + fr, col0 = u.pn * BM + wc * 32 + 8 * fq;
#pragma unroll
        for (int ai = 0; ai < 2; ++ai)
#pragma unroll
            for (int m = 0; m < 4; ++m) { bf16_t* rowp = O + (size_t)(row0 + ai * HALF + m * 16) * ldc + col0;
#pragma unroll
                for (int bj = 0; bj < 2; ++bj) { const f32x4 v0 = acc[ai][bj][m][0], v1 = acc[ai][bj][m][1];
                    u32x4 w; w.x = cvt_pk_bf16(v0[0], v0[1]); w.y = cvt_pk_bf16(v0[2], v0[3]); w.z = cvt_pk_bf16(v1[0], v1[1]); w.w = cvt_pk_bf16(v1[2], v1[3]);
                    *(u32x4*)(rowp + bj * HALF) = w;
                    if (u.pn == 5 && u.pm < 16) { const int row = row0 + ai * HALF + m * 16; float* o = nv + ((size_t)(row >> 8) * 512 + (row & 255)) * 256 + (col0 + bj * HALF - 1280); __builtin_nontemporal_store(v0, (f32x4*)o); __builtin_nontemporal_store(v1, (f32x4*)(o + 4)); } } }
    }
};
template <bool L1> struct EpiRes {
    static constexpr bool PERM = false, AFTER_DRAIN = false;
    const float* xa; const float* xb; const bf16_t* x1in; bf16_t* x1out; float* out; const float* mod;
    __device__ __forceinline__ void operator()(const f32x4 (&acc)[2][2][4][2], const Unit& u, int wr, int wc, int fr, int fq) const {
        const int row0 = u.pm * BM + wr * 64 + fr, col0 = u.pn * BM + wc * 32 + 4 * fq;
        const int ci = u.pm < 16 ? 0 : 1 + ((u.pm - 16) >> 2);
        const float* gate = mod + ci * 6144 + 4096;
        f32x4 gv[2][2];
#pragma unroll
        for (int bj = 0; bj < 2; ++bj)
#pragma unroll
            for (int n = 0; n < 2; ++n) gv[bj][n] = *(const f32x4*)(gate + col0 + bj * HALF + n * 16);
#pragma unroll
        for (int ai = 0; ai < 2; ++ai)
#pragma unroll
            for (int m = 0; m < 4; ++m) { const int r = row0 + ai * HALF + m * 16;
                const float* xin = (u.pm < 16) ? xa + (size_t)r * 2048 : xb + (size_t)(r - 4096) * 2048;
#pragma unroll
                for (int bj = 0; bj < 2; ++bj)
#pragma unroll
                    for (int n = 0; n < 2; ++n) { const int c = col0 + bj * HALF + n * 16;
                        if constexpr (L1) { const unsigned long long xw = __builtin_nontemporal_load((const unsigned long long*)(x1in + (size_t)r * 2048 + c));
                            f32x4 xv; xv[0] = __uint_as_float((unsigned)xw << 16); xv[1] = __uint_as_float((unsigned)xw & 0xffff0000u); xv[2] = __uint_as_float((unsigned)(xw >> 32) << 16); xv[3] = __uint_as_float((unsigned)(xw >> 32) & 0xffff0000u);
                            __builtin_nontemporal_store(xv + gv[bj][n] * acc[ai][bj][m][n], (f32x4*)(out + (size_t)r * 2048 + c)); }
                        else { const f32x4 xv = __builtin_nontemporal_load((const f32x4*)(xin + c)); const f32x4 y = xv + gv[bj][n] * acc[ai][bj][m][n];
                            const unsigned long long w = (unsigned long long)cvt_pk_bf16(y[0], y[1]) | ((unsigned long long)cvt_pk_bf16(y[2], y[3]) << 32);
                            *(unsigned long long*)(x1out + (size_t)r * 2048 + c) = w; } } }
    }
};
template <class Epi, class Sched, bool ALIGN_EPI = false, bool SP2 = false>
__device__ __forceinline__ void gemm_phase(PG8_LAS unsigned char* lds, const Gemm g, const Sched& S, const Epi& E) {
    int tid_ = threadIdx.x; asm volatile("" : "+v"(tid_));
    const int tid = tid_, wid = __builtin_amdgcn_readfirstlane(tid >> 6), lane = tid & 63, wr = wid >> 2, wc = wid & 3, fr = lane & 15, fq = lane >> 4;
    const int K = g.K, nt = K / BK;
    unsigned voffA[2], voffB[2];
#pragma unroll
    for (int i = 0; i < 2; ++i) { int R, C; stage_rc(tid * 16 + i * 8192, R, C); const int Rb = Epi::PERM ? ((R & ~31) + perm32(R & 31)) : R;
        voffA[i] = (unsigned)(R * K + C) * 2u; voffB[i] = (unsigned)(Rb * K + C) * 2u; }
    const size_t kstep = (size_t)(BK * 2);
    const size_t hstep = (size_t)HALF * K * 2;
    const size_t tstep = 2 * hstep;
    const unsigned ldsw = (unsigned)wid * 1024u;
    const int aoff = lds_byte(wr * 64 + fr, fq * 8), boff = lds_byte(wc * 32 + fr, fq * 8);
#define PG8_SA(b, h) (((b) * 2 + (h)) * HTB)
#define PG8_SB(b, h) ((4 + (b) * 2 + (h)) * HTB)
#define PG8_STAGE(bufoff, gbase, voff) do { _Pragma("unroll") for (int _i = 0; _i < 2; ++_i) \
        __builtin_amdgcn_global_load_lds((const unsigned*)((const char*)(gbase) + (voff)[_i]), (PG8_LAS unsigned*)(lds + (bufoff) + ldsw + _i * 8192), 16, 0, 0); } while (0)
#define PG8_LDA(dst, b, h) do { _Pragma("unroll") for (int m = 0; m < 4; ++m) _Pragma("unroll") for (int k = 0; k < 2; ++k) dst[m][k] = *(const PG8_LAS bf16x8*)(lds + PG8_SA(b, h) + aoff + m * 2048 + k * 1024); } while (0)
#define PG8_LDB(dst, b, h) do { _Pragma("unroll") for (int n = 0; n < 2; ++n) _Pragma("unroll") for (int k = 0; k < 2; ++k) dst[n][k] = *(const PG8_LAS bf16x8*)(lds + PG8_SB(b, h) + boff + n * 2048 + k * 1024); } while (0)
#define PG8_MMA(ai, bj, At, Bt) do { __builtin_amdgcn_s_setprio(1); _Pragma("unroll") for (int m = 0; m < 4; ++m) _Pragma("unroll") for (int n = 0; n < 2; ++n) _Pragma("unroll") for (int k = 0; k < 2; ++k) \
        acc[ai][bj][m][n] = __builtin_amdgcn_mfma_f32_16x16x32_bf16(Bt[n][k], At[m][k], acc[ai][bj][m][n], 0, 0, 0); __builtin_amdgcn_s_setprio(0); } while (0)
#define PG8_WAIT_V(n) asm volatile("s_waitcnt vmcnt(" #n ")" ::: "memory")
#define PG8_WAIT_L(n) asm volatile("s_waitcnt lgkmcnt(" #n ")" ::: "memory")
#define PG8_BAR __builtin_amdgcn_s_barrier()
#define PG8_SCHED __builtin_amdgcn_sched_barrier(0)
    Unit cur, nxt; int ui = 0;
    if (!S.next(0, cur)) return;
    f32x4 acc[2][2][4][2];
#pragma unroll
    for (int a = 0; a < 2; ++a)
#pragma unroll
        for (int b = 0; b < 2; ++b)
#pragma unroll
            for (int m = 0; m < 4; ++m)
#pragma unroll
                for (int n = 0; n < 2; ++n) acc[a][b][m][n] = (f32x4){0.f, 0.f, 0.f, 0.f};
    bf16x8 At[4][2], B0[2][2], B1[2][2];
    const char* cA = (const char*)g.A + (size_t)cur.pm * tstep; const char* cB = (const char*)g.Bt + (size_t)cur.pn * tstep;
    S.a_ready(cur);
    if constexpr (SP2) {
        PG8_STAGE(PG8_SB(0, 0), cB, voffB); PG8_STAGE(PG8_SB(0, 1), cB + hstep, voffB); PG8_STAGE(PG8_SA(0, 0), cA, voffA); PG8_STAGE(PG8_SA(0, 1), cA + hstep, voffA);
        if (wr == 1) PG8_BAR;
        PG8_WAIT_V(2); PG8_BAR;
        PG8_STAGE(PG8_SB(1, 0), cB + kstep, voffB); PG8_STAGE(PG8_SA(1, 0), cA + kstep, voffA); PG8_STAGE(PG8_SB(1, 1), cB + hstep + kstep, voffB);
        PG8_WAIT_V(6); PG8_BAR;
    } else {
        PG8_STAGE(PG8_SB(0, 0), cB, voffB); PG8_STAGE(PG8_SA(0, 0), cA, voffA); PG8_STAGE(PG8_SB(0, 1), cB + hstep, voffB); PG8_STAGE(PG8_SA(0, 1), cA + hstep, voffA);
        if (wr == 1) PG8_BAR;
        PG8_WAIT_V(4); PG8_BAR;
        PG8_STAGE(PG8_SB(1, 0), cB + kstep, voffB); PG8_STAGE(PG8_SA(1, 0), cA + kstep, voffA); PG8_STAGE(PG8_SB(1, 1), cB + hstep + kstep, voffB);
        PG8_WAIT_V(6); PG8_BAR;
    }
    for (;;) {
        const bool has_next = S.next(ui + 1, nxt);
        const char* nA = has_next ? (const char*)g.A + (size_t)nxt.pm * tstep : cA; const char* nB = has_next ? (const char*)g.Bt + (size_t)nxt.pn * tstep : cB;
        for (int t = 0; t < nt; t += 2) {
            const bool last = (t == nt - 2);
            const char* a1 = cA + (size_t)(t + 1) * kstep;
            const char* a2 = last ? nA : cA + (size_t)(t + 2) * kstep; const char* b2 = last ? nB : cB + (size_t)(t + 2) * kstep;
            const char* a3 = a2 + kstep; const char* b3 = b2 + kstep;
            if (last && has_next) S.a_ready(nxt);
            if constexpr (SP2) {
            PG8_LDB(B0, 0, 0); PG8_LDB(B1, 0, 1); PG8_SCHED; PG8_LDA(At, 0, 0); PG8_STAGE(PG8_SA(1, 1), a1 + hstep, voffA);
            PG8_WAIT_V(8); PG8_WAIT_L(0); PG8_BAR; PG8_MMA(0, 0, At, B0); PG8_MMA(0, 1, At, B1); PG8_BAR; PG8_SCHED;
            PG8_LDA(At, 0, 1); PG8_STAGE(PG8_SB(0, 0), b2, voffB); PG8_STAGE(PG8_SB(0, 1), b2 + hstep, voffB); PG8_STAGE(PG8_SA(0, 0), a2, voffA);
            PG8_WAIT_V(8); PG8_WAIT_L(0); PG8_BAR; PG8_MMA(1, 0, At, B0); PG8_MMA(1, 1, At, B1); PG8_BAR; PG8_SCHED;
            PG8_LDB(B0, 1, 0); PG8_LDB(B1, 1, 1); PG8_SCHED; PG8_LDA(At, 1, 0); PG8_STAGE(PG8_SA(0, 1), a2 + hstep, voffA);
            PG8_WAIT_V(8); PG8_WAIT_L(0); PG8_BAR; PG8_MMA(0, 0, At, B0); PG8_MMA(0, 1, At, B1); PG8_BAR; PG8_SCHED;
            PG8_LDA(At, 1, 1); PG8_STAGE(PG8_SB(1, 0), b3, voffB); PG8_STAGE(PG8_SB(1, 1), b3 + hstep, voffB); PG8_STAGE(PG8_SA(1, 0), a3, voffA);
            PG8_WAIT_V(8); PG8_WAIT_L(0); PG8_BAR; PG8_MMA(1, 0, At, B0); PG8_MMA(1, 1, At, B1); PG8_BAR; PG8_SCHED;
            } else {
            PG8_LDB(B0, 0, 0); PG8_SCHED; PG8_LDA(At, 0, 0); PG8_STAGE(PG8_SA(1, 1), a1 + hstep, voffA);
            PG8_WAIT_L(8); PG8_BAR; PG8_WAIT_L(0); PG8_MMA(0, 0, At, B0); PG8_BAR; PG8_SCHED;
            PG8_LDB(B1, 0, 1); PG8_STAGE(PG8_SB(0, 0), b2, voffB);
            PG8_BAR; PG8_WAIT_L(0); PG8_MMA(0, 1, At, B1); PG8_BAR;
            PG8_LDA(At, 0, 1); PG8_STAGE(PG8_SA(0, 0), a2, voffA);
            PG8_BAR; PG8_WAIT_L(0); PG8_MMA(1, 0, At, B0); PG8_BAR; PG8_SCHED;
            PG8_STAGE(PG8_SB(0, 1), b2 + hstep, voffB);
            PG8_WAIT_V(6); PG8_BAR; PG8_MMA(1, 1, At, B1); PG8_BAR;
            PG8_LDB(B0, 1, 0); PG8_SCHED; PG8_LDA(At, 1, 0); PG8_STAGE(PG8_SA(0, 1), a2 + hstep, voffA);
            PG8_WAIT_L(8); PG8_BAR; PG8_WAIT_L(0); PG8_MMA(0, 0, At, B0); PG8_BAR; PG8_SCHED;
            PG8_LDB(B1, 1, 1); PG8_STAGE(PG8_SB(1, 0), b3, voffB);
            PG8_BAR; PG8_WAIT_L(0); PG8_MMA(0, 1, At, B1); PG8_BAR;
            PG8_LDA(At, 1, 1); PG8_STAGE(PG8_SA(1, 0), a3, voffA);
            PG8_BAR; PG8_WAIT_L(0); PG8_MMA(1, 0, At, B0); PG8_BAR; PG8_SCHED;
            PG8_STAGE(PG8_SB(1, 1), b3 + hstep, voffB);
            PG8_WAIT_V(6); PG8_BAR; PG8_MMA(1, 1, At, B1); PG8_BAR;
            }
        }
        if constexpr (ALIGN_EPI) { if (wr == 0) PG8_BAR; }
        if constexpr (!Epi::AFTER_DRAIN) { E(acc, cur, wr, wc, fr, fq); S.done(cur); }
        if (!has_next) break;
#pragma unroll
        for (int a = 0; a < 2; ++a)
#pragma unroll
            for (int b = 0; b < 2; ++b)
#pragma unroll
                for (int m = 0; m < 4; ++m)
#pragma unroll
                    for (int n = 0; n < 2; ++n) acc[a][b][m][n] = (f32x4){0.f, 0.f, 0.f, 0.f};
        cur = nxt; cA = nA; cB = nB; ++ui;
        if constexpr (ALIGN_EPI) { if (wr == 1) PG8_BAR; }
    }
    PG8_WAIT_V(0);
    if constexpr (!ALIGN_EPI) { if (wr == 0) PG8_BAR; }
    PG8_BAR;
    if constexpr (Epi::AFTER_DRAIN) { E.fused(acc, cur, wr, wc, fr, fq, lds, wid, lane); S.done(cur); }
#undef PG8_SA
#undef PG8_SB
#undef PG8_STAGE
#undef PG8_LDA
#undef PG8_LDB
#undef PG8_MMA
#undef PG8_WAIT_V
#undef PG8_WAIT_L
#undef PG8_BAR
#undef PG8_SCHED
}

}

namespace att {
using bf16 = unsigned short;
constexpr int   D = 128, NW = 8, QBLK = 32, KVBLK = 64;
constexpr float SCALE = 0.088388347648318440f;
constexpr float THR = 8.f;
constexpr int SDEPTH = 1;
constexpr int LDQ = 128, LDK = 128;
constexpr size_t SHM_V = KVBLK * D * 2, SHM_K = KVBLK * D * 2, SHM_ATTN = 2 * SHM_V + 2 * SHM_K + NW * 64 * 4;
using bf16x8 = __attribute__((ext_vector_type(8))) short;
using s16x4  = __attribute__((ext_vector_type(4))) short;
using f32x16 = __attribute__((ext_vector_type(16))) float;
using f32x8  = __attribute__((ext_vector_type(8))) float;
using u32x4  = __attribute__((ext_vector_type(4))) unsigned;
#define KSWZ(row, colB) ((row) * 256 + ((colB) ^ (((row) & 7) << 4)))
#define SBAR() __builtin_amdgcn_sched_barrier(0)
__device__ __forceinline__ int crow(int r, int hi) { return (r & 3) + 8 * (r >> 2) + 4 * hi; }
__device__ __forceinline__ unsigned cvtpk(float lo, float hi) {
  unsigned r; asm volatile("v_cvt_pk_bf16_f32 %0, %1, %2" : "=v"(r) : "v"(lo), "v"(hi)); return r;
}
template <typename TIn> struct Stage;
template <> struct Stage<bf16>  { using T = bf16x8;
  __device__ static __forceinline__ T ld8(const bf16* p) { return *reinterpret_cast<const bf16x8*>(p); }
  __device__ static __forceinline__ bf16x8 tobf(T x) { return x; } };
template <> struct Stage<float> { using T = f32x8;
  __device__ static __forceinline__ T ld8(const float* p) { return *reinterpret_cast<const f32x8*>(p); }
  __device__ static __forceinline__ bf16x8 tobf(T x) {
    u32x4 w = {cvtpk(x[0], x[1]), cvtpk(x[2], x[3]), cvtpk(x[4], x[5]), cvtpk(x[6], x[7])}; return *reinterpret_cast<bf16x8*>(&w); } };

__device__ __forceinline__ void partialSM(f32x16& p0, f32x16& p1, float& m_reg, float& mn, float& alpha) {
  constexpr float C = SCALE * 1.4426950408889634f;
  float pmax = p0[0]; for (int r = 1; r < 16; ++r) pmax = fmaxf(pmax, p0[r]); for (int r = 0; r < 16; ++r) pmax = fmaxf(pmax, p1[r]);
  { auto rr = __builtin_amdgcn_permlane32_swap(__float_as_uint(pmax), __float_as_uint(pmax), false, false);
    pmax = fmaxf(__uint_as_float(rr[0]), __uint_as_float(rr[1])); }
  if (__builtin_expect(__all(pmax - m_reg <= THR / SCALE), 1)) { mn = m_reg; alpha = 1.f; }
  else { mn = fmaxf(m_reg, pmax); alpha = __builtin_amdgcn_exp2f((m_reg - mn) * C); m_reg = mn; }
  float mnC = -mn * C;
  for (int r = 0; r < 16; ++r) p0[r] = fmaf(p0[r], C, mnC); for (int r = 0; r < 16; ++r) p1[r] = fmaf(p1[r], C, mnC);
  for (int r = 0; r < 16; ++r) p0[r] = __builtin_amdgcn_exp2f(p0[r]);
}
__device__ __forceinline__ void finishSM(f32x16& p0, f32x16& p1, float alpha, float& l_reg, bf16x8& pa0, bf16x8& pa1, bf16x8& pa2, bf16x8& pa3) {
  for (int r = 0; r < 16; ++r) p1[r] = __builtin_amdgcn_exp2f(p1[r]);
  float ps = 0; for (int r = 0; r < 16; ++r) ps += p0[r]; for (int r = 0; r < 16; ++r) ps += p1[r];
  { auto rr = __builtin_amdgcn_permlane32_swap(__float_as_uint(ps), __float_as_uint(ps), false, false);
    ps = __uint_as_float(rr[0]) + __uint_as_float(rr[1]); }
  l_reg = l_reg * alpha + ps;
#define PK4(P, BASE, OUT) do { unsigned a0 = cvtpk(P[BASE + 0], P[BASE + 1]), a1 = cvtpk(P[BASE + 2], P[BASE + 3]);   \
    unsigned b0 = cvtpk(P[BASE + 4], P[BASE + 5]), b1 = cvtpk(P[BASE + 6], P[BASE + 7]);                              \
    auto r0 = __builtin_amdgcn_permlane32_swap(a0, b0, false, false); auto r1 = __builtin_amdgcn_permlane32_swap(a1, b1, false, false); \
    u32x4 w = {r0[0], r1[0], r0[1], r1[1]}; OUT = *reinterpret_cast<bf16x8*>(&w); } while (0)
  PK4(p0, 0, pa0); PK4(p0, 8, pa1); PK4(p1, 0, pa2); PK4(p1, 8, pa3);
#undef PK4
}
__device__ __forceinline__ void qkt(f32x16& p0, f32x16& p1, const bf16* Ks, const bf16x8* qr, int r32, int hi) {
  p0 = f32x16{}; p1 = f32x16{};
  for (int d0 = 0; d0 < 8; ++d0) { int cb = (d0 * 16 + hi * 8) * 2;
    bf16x8 b0 = *reinterpret_cast<const bf16x8*>((const char*)Ks + KSWZ(r32, cb));
    bf16x8 b1 = *reinterpret_cast<const bf16x8*>((const char*)Ks + KSWZ(32 + r32, cb));
    p0 = __builtin_amdgcn_mfma_f32_32x32x16_bf16(b0, qr[d0], p0, 0, 0, 0);
    p1 = __builtin_amdgcn_mfma_f32_32x32x16_bf16(b1, qr[d0], p1, 0, 0, 0); }
}
__device__ __forceinline__ int v_st(int k, int c) { const int kk = (k & ~0xC) | ((k & 4) << 1) | ((k & 8) >> 1); return ((kk >> 3) * 4 + (c >> 5)) * 512 + ((kk & 7) * 32 + (c & 31)) * 2; }
__device__ __forceinline__ int v_rd_base(int lane) { return ((lane & 3) << 3) | (((lane >> 2) & 3) << 6) | (((lane >> 4) & 1) << 5) | (((lane >> 5) & 1) << 8); }
constexpr int v_rd_off(int d0, int ks, int half) { return d0 * 512 + ks * 4096 + half * 2048; }
template <int OFF> __device__ __forceinline__ s16x4 tr_read(int vb) {
  s16x4 r; asm volatile("ds_read_b64_tr_b16 %0, %1 offset:%2" : "=&v"(r) : "v"(vb), "i"(OFF) : "memory"); return r;
}
template <int D0> __device__ __forceinline__ void pv_one(f32x16& od, int vb, bf16x8 pa0, bf16x8 pa1, bf16x8 pa2, bf16x8 pa3) {
  const s16x4 l0 = tr_read<v_rd_off(D0, 0, 0)>(vb), h0 = tr_read<v_rd_off(D0, 0, 1)>(vb), l1 = tr_read<v_rd_off(D0, 1, 0)>(vb), h1 = tr_read<v_rd_off(D0, 1, 1)>(vb);
  const s16x4 l2 = tr_read<v_rd_off(D0, 2, 0)>(vb), h2 = tr_read<v_rd_off(D0, 2, 1)>(vb), l3 = tr_read<v_rd_off(D0, 3, 0)>(vb), h3 = tr_read<v_rd_off(D0, 3, 1)>(vb);
  asm volatile("s_waitcnt lgkmcnt(0)" ::: "memory"); SBAR();
#define PK(L, H) (bf16x8){L[0], L[1], L[2], L[3], H[0], H[1], H[2], H[3]}
  od = __builtin_amdgcn_mfma_f32_32x32x16_bf16(pa0, PK(l0, h0), od, 0, 0, 0);
  od = __builtin_amdgcn_mfma_f32_32x32x16_bf16(pa1, PK(l1, h1), od, 0, 0, 0);
  od = __builtin_amdgcn_mfma_f32_32x32x16_bf16(pa2, PK(l2, h2), od, 0, 0, 0);
  od = __builtin_amdgcn_mfma_f32_32x32x16_bf16(pa3, PK(l3, h3), od, 0, 0, 0);
#undef PK
}
__device__ __forceinline__ void pv_d0(f32x16* o, int vb, bf16x8 pa0, bf16x8 pa1, bf16x8 pa2, bf16x8 pa3) {
  pv_one<0>(o[0], vb, pa0, pa1, pa2, pa3); pv_one<1>(o[1], vb, pa0, pa1, pa2, pa3); pv_one<2>(o[2], vb, pa0, pa1, pa2, pa3); pv_one<3>(o[3], vb, pa0, pa1, pa2, pa3);
}


__device__ __forceinline__ void attn_dense_body(const bf16* __restrict__ Qb, const bf16* __restrict__ Kh, const bf16* __restrict__ Vc, const bf16* __restrict__ Vz, int vsplit,
                                                const float* __restrict__ qnw, const float* __restrict__ rope, int tq0, bool do_rope,
                                                bf16* __restrict__ Mix, const bf16* __restrict__ Ag, int seq, char* lds) {
  using TQ = bf16;
  using St = Stage<bf16>; using SQ = Stage<TQ>;
  int tid_ = threadIdx.x; asm volatile("" : "+v"(tid_));
  const int tid = tid_, wid = tid >> 6, lane = tid & 63, r32 = lane & 31, hi = lane >> 5;
  bf16* V_lds = (bf16*)lds; bf16* K_lds = (bf16*)(lds + 2 * SHM_V);
  float* ws = (float*)(lds + 2 * SHM_V + 2 * SHM_K) + wid * 64; float* li_l = ws; float* al_l = ws + 32;
  float m_reg = -1e30f, l_reg = 0; f32x16 o[4] = {}; bf16x8 qr[8];
  const TQ* Qw = Qb + (long)(wid * QBLK + r32) * 6144 + hi * 8;
#pragma unroll
  for (int d0 = 0; d0 < 8; ++d0) qr[d0] = SQ::tobf(SQ::ld8(Qw + d0 * 16));
  {
    float xq[8][8]; float ss = 0.f;
#pragma unroll
    for (int d0 = 0; d0 < 8; ++d0)
#pragma unroll
      for (int j = 0; j < 8; ++j) { xq[d0][j] = __uint_as_float(((unsigned)(unsigned short)qr[d0][j]) << 16); ss += xq[d0][j] * xq[d0][j]; }
    ss += __shfl_xor(ss, 32);
    const float rstd = rsqrtf(ss * (1.f / 128.f) + 1e-6f);
#pragma unroll
    for (int d0 = 0; d0 < 8; ++d0) { const float* wp = qnw + d0 * 16 + hi * 8;
#pragma unroll
      for (int j = 0; j < 8; ++j) xq[d0][j] *= rstd * wp[j]; }
    if (do_rope) { const int t = tq0 + wid * QBLK + r32, prow = t >> 6, pcol = t & 63;
#pragma unroll
      for (int g = 0; g < 2; ++g)
#pragma unroll
        for (int e = 0; e < 2; ++e) { const int d0 = 4 * g + e; const float* cs = rope + ((g ? pcol : prow) * 32 + 16 * e + 8 * hi) * 2;
#pragma unroll
          for (int j = 0; j < 8; ++j) { const float c = cs[2 * j], sn = cs[2 * j + 1], y1 = xq[d0][j], y2 = xq[d0 + 2][j];
            xq[d0][j] = y1 * c - y2 * sn; xq[d0 + 2][j] = y1 * sn + y2 * c; } } }
#pragma unroll
    for (int d0 = 0; d0 < 8; ++d0) { u32x4 w = {cvtpk(xq[d0][0], xq[d0][1]), cvtpk(xq[d0][2], xq[d0][3]), cvtpk(xq[d0][4], xq[d0][5]), cvtpk(xq[d0][6], xq[d0][7])}; qr[d0] = *reinterpret_cast<bf16x8*>(&w); }
  }
  const int voffc = (tid >> 4) * 128 + (tid & 15) * 8;
  const int sr = tid >> 4, sc = (tid & 15) * 8, vst0 = v_st(sr, sc), vst1 = v_st(32 + sr, sc);
  const int vb0 = (int)(uintptr_t)V_lds + v_rd_base(lane);
  struct { typename St::T vs0, vs1, ks0, ks1; } sr_[SDEPTH];
#define SLOAD(i, k0) do { const bool vc_ = (k0) < vsplit; const bf16* vb_ = vc_ ? Vc + (long)(k0) * 128 : Vz + (long)((k0) - vsplit) * 6144; const int vo_ = vc_ ? voffc : voffc + (tid >> 4) * 6016, v32_ = vc_ ? 32 * 128 : 32 * 6144; \
    sr_[i].vs0 = St::ld8(&vb_[vo_]); sr_[i].vs1 = St::ld8(&vb_[vo_ + v32_]); \
    sr_[i].ks0 = St::ld8(&Kh[(long)((k0) + sr) * LDK + sc]); sr_[i].ks1 = St::ld8(&Kh[(long)((k0) + 32 + sr) * LDK + sc]); } while (0)
#define SWRITE(b, i) do { *(bf16x8*)((char*)V_lds + (b) * SHM_V + vst0) = St::tobf(sr_[i].vs0);          \
    *(bf16x8*)((char*)V_lds + (b) * SHM_V + vst1) = St::tobf(sr_[i].vs1); int kc = sc * 2;               \
    *(bf16x8*)((char*)K_lds + (b) * SHM_K + KSWZ(sr, kc)) = St::tobf(sr_[i].ks0);                       \
    *(bf16x8*)((char*)K_lds + (b) * SHM_K + KSWZ(32 + sr, kc)) = St::tobf(sr_[i].ks1); } while (0)
#define SWAIT() do { if constexpr (SDEPTH == 2) asm volatile("s_waitcnt vmcnt(4)" ::: "memory"); else asm volatile("s_waitcnt vmcnt(0)" ::: "memory"); } while (0)
#define RESC(a) do { if (__any((a) < 1.f)) { if (hi == 0) al_l[r32] = (a); asm volatile("s_waitcnt lgkmcnt(0)" ::: "memory"); \
    for (int d = 0; d < 4; ++d) for (int r = 0; r < 16; ++r) o[d][r] *= al_l[crow(r, hi)]; } } while (0)
  f32x16 pA0, pA1, pB0, pB1; float mnA, mnB, alA, alB; bf16x8 pa0, pa1, pa2, pa3; const int NT = seq / KVBLK;
  constexpr int SE = 0, SO = SDEPTH - 1;
  SLOAD(SE, 0); asm volatile("s_waitcnt vmcnt(0)" ::: "memory"); SWRITE(0, SE); __syncthreads();
  qkt(pA0, pA1, K_lds, qr, r32, hi); partialSM(pA0, pA1, m_reg, mnA, alA);
  SLOAD(SO, KVBLK); if constexpr (SDEPTH == 2) { if (2 < NT) SLOAD(SE, 2 * KVBLK); }
  SWAIT(); SWRITE(1, SO); __syncthreads();
  for (int j = 1; j + 1 < NT; j += 2) {
    SBAR(); qkt(pB0, pB1, (bf16*)((char*)K_lds + SHM_K), qr, r32, hi);
    finishSM(pA0, pA1, alA, l_reg, pa0, pa1, pa2, pa3); SBAR();
    SLOAD(SO, (j + SDEPTH) * KVBLK); SBAR();
    pv_d0(o, vb0, pa0, pa1, pa2, pa3); partialSM(pB0, pB1, m_reg, mnB, alB);
    __syncthreads(); SWAIT(); SWRITE(0, SE);
    RESC(alB); __syncthreads();
    SBAR(); qkt(pA0, pA1, K_lds, qr, r32, hi);
    finishSM(pB0, pB1, alB, l_reg, pa0, pa1, pa2, pa3); SBAR();
    if (SDEPTH == 1 || j + 3 < NT) SLOAD(SE, (j + 1 + SDEPTH) * KVBLK); SBAR();
    pv_d0(o, vb0 + (int)SHM_V, pa0, pa1, pa2, pa3); partialSM(pA0, pA1, m_reg, mnA, alA);
    __syncthreads(); SWAIT(); SWRITE(1, SO);
    RESC(alA); __syncthreads();
  }
  SBAR(); qkt(pB0, pB1, (bf16*)((char*)K_lds + SHM_K), qr, r32, hi);
  finishSM(pA0, pA1, alA, l_reg, pa0, pa1, pa2, pa3); SBAR();
  pv_d0(o, vb0, pa0, pa1, pa2, pa3); partialSM(pB0, pB1, m_reg, mnB, alB);
  __syncthreads(); RESC(alB);
  finishSM(pB0, pB1, alB, l_reg, pa0, pa1, pa2, pa3); SBAR();
  pv_d0(o, vb0 + (int)SHM_V, pa0, pa1, pa2, pa3);
  if (hi == 0) li_l[r32] = l_reg; asm volatile("s_waitcnt lgkmcnt(0)" ::: "memory");
  float rli[16];
#pragma unroll
  for (int r = 0; r < 16; ++r) rli[r] = __builtin_amdgcn_rcpf(li_l[crow(r, hi)]);
  bf16* Mw = Mix + (long)(wid * QBLK) * 2048; const bf16* Aw = Ag + (long)(wid * QBLK) * 6144;
#pragma unroll
  for (int r = 0; r < 16; ++r) { int orow = crow(r, hi);
#pragma unroll
    for (int d0 = 0; d0 < 4; ++d0) { const float g = __uint_as_float(((unsigned)Aw[(long)orow * 6144 + d0 * 32 + r32]) << 16);
      const float val = o[d0][r] * rli[r] * (g * __builtin_amdgcn_rcpf(1.f + __expf(-g)));
      Mw[(long)orow * 2048 + d0 * 32 + r32] = (bf16)cvtpk(val, val); } }
#undef SLOAD
#undef SWRITE
#undef SWAIT
#undef RESC
}

}

#define DI __device__ __forceinline__
#define LAS __attribute__((address_space(3)))
typedef unsigned short bf16_t;
typedef short bf16x8 __attribute__((ext_vector_type(8)));
typedef float f32x4 __attribute__((ext_vector_type(4)));
typedef float f32x16 __attribute__((ext_vector_type(16)));
typedef unsigned u32x4 __attribute__((ext_vector_type(4)));
typedef unsigned u32x2 __attribute__((ext_vector_type(2)));
#define TID_SETUP int tid = threadIdx.x; asm volatile("" : "+v"(tid)); const int lane = tid & 63, wave = __builtin_amdgcn_readfirstlane(tid >> 6); (void)lane; (void)wave;
#define MFMA32(a, b, c) __builtin_amdgcn_mfma_f32_32x32x16_bf16((a), (b), (c), 0, 0, 0)

#define XB_TMO      128
#define XB_XCNT(j)  (256  + 64 * (j))
#define XB_XSUB(j)  (1280 + 64 * (j))
#define XB_XGEN(j)  (2304 + 64 * (j))
#define XB_TOP      3328
#define XB_TOPGEN   3392
#define XCD_BAR_WORDS 3456
#define XB_SPIN_CAP (1u << 18)
__device__ __forceinline__ unsigned xb_ld(unsigned* p)              { return __hip_atomic_load(p, __ATOMIC_RELAXED, __HIP_MEMORY_SCOPE_AGENT); }
__device__ __forceinline__ unsigned xb_add(unsigned* p, unsigned v) { return __hip_atomic_fetch_add(p, v, __ATOMIC_RELAXED, __HIP_MEMORY_SCOPE_AGENT); }
__device__ __forceinline__ unsigned xb_xcc_id() { return (unsigned)__builtin_amdgcn_s_getreg((3 << 11) | 20) & 0xFu; }
#define XB_SPIN(cond, bar) do { unsigned _sp = 0; while (cond) { __builtin_amdgcn_s_sleep(1); \
    if ((++_sp & 255u) == 0u) { if (xb_ld(&(bar)[XB_TMO])) break; if (_sp > XB_SPIN_CAP) { atomicAdd(&(bar)[XB_TMO], 1u); break; } } } } while (0)

struct XcdBarrier {
    unsigned* bar; unsigned x;
    volatile LAS unsigned* st;
};

__device__ __forceinline__ XcdBarrier xcd_barrier_post(unsigned* bar, volatile LAS unsigned* st) {
    XcdBarrier b; b.bar = bar; b.x = xb_xcc_id(); b.st = st;
    if (threadIdx.x == 0) (void)xb_add(&bar[XB_XCNT(b.x)], 1u);
    return b;
}
__device__ __forceinline__ void xcd_barrier_complete(unsigned* bar, unsigned x, unsigned& nloc, unsigned& nx) {
    const unsigned G = gridDim.x * gridDim.y * gridDim.z;
    unsigned sum, cnt, mine, sp = 0u;
    for (;;) {
        sum = 0u; cnt = 0u; mine = 0u;
#pragma unroll
        for (unsigned j = 0; j < 16; ++j) { const unsigned c = xb_ld(&bar[XB_XCNT(j)]); sum += c; cnt += (c > 0u) ? 1u : 0u; mine = (j == x) ? c : mine; }
        if (sum == G) break;
        __builtin_amdgcn_s_sleep(1);
        if ((++sp & 255u) == 0u) { if (xb_ld(&bar[XB_TMO])) break; if (sp > XB_SPIN_CAP) { atomicAdd(&bar[XB_TMO], 1u); break; } }
    }
    nloc = mine > 0u ? mine : 1u; nx = cnt > 0u ? cnt : 1u;
}

__device__ __forceinline__ void xcd_barrier(const XcdBarrier& b) {
    asm volatile("s_waitcnt vmcnt(0)" ::: "memory");
    __syncthreads();
    if (threadIdx.x == 0) {
        unsigned* bar = b.bar;
        __builtin_amdgcn_s_waitcnt(0);
        unsigned nloc = b.st[0], nx = b.st[1];
        if (nloc == 0u) { xcd_barrier_complete(bar, b.x, nloc, nx); b.st[0] = nloc; b.st[1] = nx; }
        const unsigned old = xb_add(&bar[XB_XSUB(b.x)], 1u);
        const unsigned gen = old / nloc;
        if (old + 1u == (gen + 1u) * nloc) {
            __builtin_amdgcn_fence(__ATOMIC_RELEASE, "agent");
            asm volatile("s_waitcnt vmcnt(0)" ::: "memory");
            const unsigned og = xb_add(&bar[XB_TOP], 1u);
            const unsigned tg = og / nx;
            if (og + 1u == (tg + 1u) * nx) xb_add(&bar[XB_TOPGEN], 1u);
            else XB_SPIN(xb_ld(&bar[XB_TOPGEN]) == tg, bar);
            __builtin_amdgcn_fence(__ATOMIC_ACQUIRE, "agent");
            xb_add(&bar[XB_XGEN(b.x)], 1u);
            asm volatile("s_waitcnt vmcnt(0)" ::: "memory");
        } else {
            XB_SPIN(xb_ld(&bar[XB_XGEN(b.x)]) == gen, bar);
            __builtin_amdgcn_fence(__ATOMIC_ACQUIRE, "agent");
            asm volatile("s_waitcnt vmcnt(0)" ::: "memory");
        }
    }
    __syncthreads();
}

constexpr int NTOK = 8192, DM = 2048, NZ = 6144;
constexpr int ZQ = 0, ZK = 1024, ZV = 1280, ZAG = 1536, ZMQ = 2560, ZMK = 3072, ZMV = 3584, ZMO = 4096, ZMG = 4608, ZFX = 5120, ZFG = 5632;
constexpr float EPS = 1e-6f;
constexpr size_t O_YP = 0, O_YS = 8388608, O_NK = 16777216, O_NV = 18874368, O_NC = 20971520, O_NN = 25165824, O_NM = 25198592, O_END = 25198848;
constexpr size_t WS_CTL = 0;
constexpr size_t WS_BAR = 16384;
constexpr size_t WS_MOD = 32768;
constexpr size_t WS_GATES = WS_MOD + 245760;
constexpr size_t WS_ROPE = WS_GATES + 524288;
constexpr size_t WS_WG = WS_ROPE + 16384;
constexpr size_t WS_CSW = WS_WG + 131072;
constexpr size_t WS_DFTC = WS_CSW + 524288;
constexpr size_t WS_DFTL = WS_DFTC + 262144;
constexpr size_t WS_WINT = WS_DFTL + 4194304;
constexpr size_t WS_WOUTT = WS_WINT + 50331648;
constexpr size_t WS_H = WS_WOUTT + 16777216;
constexpr size_t WS_Z = WS_H + 33554432;
constexpr size_t WS_Q = WS_Z + 100663296;
constexpr size_t WS_K = WS_Q + 16777216;
constexpr size_t WS_V = WS_K + 8388608;
constexpr size_t WS_MQ = WS_V + 8388608;
constexpr size_t WS_X1B = WS_MQ;
constexpr size_t WS_MK = WS_MQ + 8388608;
constexpr size_t WS_MKT = WS_MK + 8388608;
constexpr size_t WS_MVT = WS_MKT + 8388608;
constexpr size_t WS_XT = WS_MVT + 8388608;
constexpr size_t WS_GS = WS_XT + 8388608;
constexpr size_t WS_DEC = WS_GS + 1310720;
constexpr size_t WS_U = WS_DEC + 4096;
constexpr size_t WS_UN = WS_U + 67108864;
constexpr size_t WS_CJ = WS_UN + 524288;
constexpr size_t WS_NJ = WS_CJ + 33554432;
constexpr size_t WS_END = WS_NJ + 524288;
constexpr int KC_ELEMS = 16 * 2 * 256 * 128;
constexpr int KL_ELEMS = 4 * 2 * 1536 * 128;
constexpr int LDS_MISC = 151552;
constexpr int LDS_BYTES = LDS_MISC + 256;

struct P { const float* in[21]; float* out; unsigned char* ws; };
enum { I_XP = 0, I_XS, I_CK, I_CV, I_SC, I_SN, I_SM, I_C, I_CCTX, I_NORMW, I_WMOD, I_BMOD, I_WIN, I_BIF, I_CONVW, I_CONVB, I_QN, I_KN, I_MLN, I_WFNO, I_WOUT };

DI unsigned pk2(float lo, float hi) { unsigned r; asm volatile("v_cvt_pk_bf16_f32 %0, %1, %2" : "=v"(r) : "v"(lo), "v"(hi)); return r; }
DI float bf2f(bf16_t v) { return __uint_as_float(((unsigned)v) << 16); }
DI float bfs2f(short v) { return __uint_as_float(((unsigned)(unsigned short)v) << 16); }
DI bf16_t f2bf(float f) { unsigned r; asm("v_cvt_pk_bf16_f32 %0, %1, %1" : "=v"(r) : "v"(f)); return (bf16_t)r; }
typedef __bf16 bf16x2_t __attribute__((ext_vector_type(2)));
DI float dot2bf(unsigned a, unsigned b, float c) { return __builtin_amdgcn_fdot2_f32_bf16(__builtin_bit_cast(bf16x2_t, a), __builtin_bit_cast(bf16x2_t, b), c, false); }
DI float wave_sum(float v) {
#pragma unroll
    for (int o = 1; o < 64; o <<= 1) v += __shfl_xor(v, o);
    return v;
}
DI float silu_f(float x) { return x * __builtin_amdgcn_rcpf(1.f + __expf(-x)); }
DI float sigm_f(float x) { return __builtin_amdgcn_rcpf(1.f + __expf(-x)); }
DI int crow(int reg, int h) { return (reg & 3) + 8 * (reg >> 2) + 4 * h; }
DI bf16x8 pack8(const float* v) { u32x4 w; w.x = pk2(v[0], v[1]); w.y = pk2(v[2], v[3]); w.z = pk2(v[4], v[5]); w.w = pk2(v[6], v[7]); return __builtin_bit_cast(bf16x8, w); }

DI void transpose_item(const float* W, int ldw, int K, bf16_t* WT, int k0, int col_src, int row_dst, LAS float* scr, int lane) {
#pragma unroll 16
    for (int i = 0; i < 32; ++i) { const int kk = 2 * i + (lane >> 5); scr[kk * 33 + (lane & 31)] = __builtin_nontemporal_load(&W[(size_t)(k0 + kk) * ldw + col_src + (lane & 31)]); }
    asm volatile("s_waitcnt lgkmcnt(0)" ::: "memory");
    const int c = lane & 7;
#pragma unroll
    for (int j = 0; j < 4; ++j) { const int n = (lane >> 3) + 8 * j; const LAS float* s = scr + (8 * c) * 33 + n;
        u32x4 o; o.x = pk2(s[0 * 33], s[1 * 33]); o.y = pk2(s[2 * 33], s[3 * 33]); o.z = pk2(s[4 * 33], s[5 * 33]); o.w = pk2(s[6 * 33], s[7 * 33]);
        *(u32x4*)(WT + (size_t)(row_dst + n) * K + k0 + 8 * c) = o; }
    asm volatile("s_waitcnt lgkmcnt(0)" ::: "memory");
}

DI void phase0(const P& p, LAS unsigned char* lds, int ctr_idx) {
    TID_SETUP
    unsigned char* ws = p.ws;
    const int G = gridDim.x, bid = blockIdx.x;
    const int gt = bid * 512 + tid, NT = G * 512;
    {
        float* rope = (float*)(ws + WS_ROPE);
        for (int i = gt; i < 2048; i += NT) { const int pos = i >> 5, f = i & 31; const float inv = exp2f(-(float)f * (13.287712379549449f / 32.f));
            float s, c; sincosf((float)pos * inv, &s, &c); rope[2 * i] = c; rope[2 * i + 1] = s; }
        bf16_t* dc = (bf16_t*)(ws + WS_DFTC);
        for (int i = gt; i < 65536; i += NT) { const int a = i >> 8, b = i & 255, m = (a * b) & 255; float s, c; sincospif((float)m * (2.f / 256.f), &s, &c);
            const float sc = 0.005524271728019903f; dc[i] = f2bf(c * sc); dc[65536 + i] = f2bf(s * sc); }
        bf16_t* dl = (bf16_t*)(ws + WS_DFTL);
        for (int i = gt; i < 1048576; i += NT) { const int a = i >> 10, b = i & 1023, m = (a * b) & 1023; float s, c; sincospif((float)m * (2.f / 1024.f), &s, &c);
            const float sc = 0.0027621358640099515f; dl[i] = f2bf(c * sc); dl[1048576 + i] = f2bf(s * sc); }
        bf16_t* wg = (bf16_t*)(ws + WS_WG); const float* win = p.in[I_WIN];
        for (int i = gt; i < 65536; i += NT) { const int l = i >> 15, n = (i >> 11) & 15, k = i & 2047; wg[i] = f2bf(win[((size_t)l * 2048 + k) * 6160 + 5120 + n]); }
        const float* ck = p.in[I_CK]; const float* cv = p.in[I_CV];
        bf16_t* Kb = (bf16_t*)(ws + WS_K) + KC_ELEMS; bf16_t* Vb = (bf16_t*)(ws + WS_V) + KC_ELEMS;
        for (int i = gt; i < 131072; i += NT) { const int d8 = i & 15, key = (i >> 4) & 511, kvh = (i >> 13) & 1, b = (i >> 14) & 3, l = i >> 16;
            const size_t src = ((((size_t)b * 2 + l) * 512 + key) * 2 + kvh) * 128 + d8 * 8;
            const size_t dst = (size_t)l * KL_ELEMS + ((size_t)(b * 2 + kvh) * 1536 + key) * 128 + d8 * 8;
            const f32x4 a0 = *(const f32x4*)(ck + src), a1 = *(const f32x4*)(ck + src + 4), b0 = *(const f32x4*)(cv + src), b1 = *(const f32x4*)(cv + src + 4);
            u32x4 wk_, wv_; wk_.x = pk2(a0[0], a0[1]); wk_.y = pk2(a0[2], a0[3]); wk_.z = pk2(a1[0], a1[1]); wk_.w = pk2(a1[2], a1[3]);
            wv_.x = pk2(b0[0], b0[1]); wv_.y = pk2(b0[2], b0[3]); wv_.z = pk2(b1[0], b1[1]); wv_.w = pk2(b1[2], b1[3]);
            *(u32x4*)(Kb + dst) = wk_; *(u32x4*)(Vb + dst) = wv_; }
    }
    for (int u = bid; u < 256; u += G) {
        const int lg = u >> 5, jr = u & 31;
        LAS float* Wl = (LAS float*)lds; LAS float* ct = (LAS float*)(lds + 65536);
        const float* wf = p.in[I_WFNO] + (size_t)lg * 16384;
        for (int i = tid; i < 4096; i += 512) ((LAS f32x4*)Wl)[i] = ((const f32x4*)wf)[i];
        if (tid < 128) ct[tid] = cospif((float)tid * (1.f / 64.f));
        __syncthreads();
        bf16_t* csw = (bf16_t*)(ws + WS_CSW);
#pragma unroll
        for (int i = 0; i < 2; ++i) { const int e = tid + 512 * i, d = e & 127, j = 8 * jr + (e >> 7); const int c = j & 127, sh = (j >= 128) ? 32 : 0;
            float acc = 0.f;
#pragma unroll 8
            for (int cp = 0; cp < 128; ++cp) acc += ct[((c * cp) - sh) & 127] * Wl[cp * 128 + d];
            csw[((size_t)lg * 128 + d) * 256 + j] = f2bf(sh ? -acc : acc); }
        __syncthreads();
    }
    for (int t = bid; t < 192; t += G) {
        const int l = t / 96, col0 = (t % 96) * 64;
        LAS float* sc = (LAS float*)lds; LAS float* red = (LAS float*)(lds + 40960);
        for (int i = tid; i < 5 * 2048; i += 512) { const int ci = i >> 11, k = i & 2047; const float cvv = ci == 0 ? p.in[I_CCTX][k] : p.in[I_C][(ci - 1) * 2048 + k]; sc[i] = cvv / (1.f + expf(-cvv)); }
        __syncthreads();
        const int cq = lane & 15, kr = lane >> 4;
        const float* wp = p.in[I_WMOD] + (size_t)l * 2048 * 6144 + col0 + 4 * cq;
        f32x4 acc[5];
#pragma unroll
        for (int ci = 0; ci < 5; ++ci) acc[ci] = (f32x4){0.f, 0.f, 0.f, 0.f};
#pragma unroll 8
        for (int it = 0; it < 64; ++it) { const int k = wave * 4 + kr + 32 * it; const f32x4 wv = __builtin_nontemporal_load((const f32x4*)(wp + (size_t)k * 6144));
#pragma unroll
            for (int ci = 0; ci < 5; ++ci) acc[ci] += wv * sc[ci * 2048 + k]; }
#pragma unroll
        for (int ci = 0; ci < 5; ++ci)
#pragma unroll
            for (int j = 0; j < 4; ++j) { float v = acc[ci][j]; v += __shfl_xor(v, 16); v += __shfl_xor(v, 32); if (kr == 0) red[(wave * 20 + ci * 4 + j) * 16 + cq] = v; }
        __syncthreads();
        if (tid < 320) { const int ci = tid >> 6, cc = tid & 63, cq2 = cc >> 2, j = cc & 3; float s = 0.f;
#pragma unroll
            for (int w = 0; w < 8; ++w) s += red[(w * 20 + ci * 4 + j) * 16 + cq2];
            ((float*)(ws + WS_MOD))[(size_t)(l * 5 + ci) * 6144 + col0 + cc] = s + p.in[I_BMOD][l * 6144 + col0 + cc]; }
        __syncthreads();
    }
    {
        LAS float* scr = (LAS float*)(lds + wave * 8448);
        unsigned* ctr = (unsigned*)(ws + WS_CTL) + ctr_idx;
        for (;;) {
            unsigned base = 0; if (lane == 0) base = atomicAdd(ctr, 8u); base = __builtin_amdgcn_readfirstlane(base);
            if (base >= 16384u) break;
#pragma unroll 1
            for (unsigned q = 0; q < 8; ++q) { const unsigned it = base + q;
                if (it < 12288u) { const int l = it / 6144, r = it % 6144, kb = r / 192, nb = r % 192; const int n0 = nb * 32;
                    transpose_item(p.in[I_WIN] + (size_t)l * 2048 * 6160, 6160, 2048, (bf16_t*)(ws + WS_WINT) + (size_t)l * 6144 * 2048, kb * 64, n0 + (n0 >= 5120 ? 16 : 0), n0, scr, lane); }
                else { const int r0 = it - 12288, l = r0 / 2048, r = r0 % 2048, kb = r / 64, nb = r % 64;
                    transpose_item(p.in[I_WOUT] + (size_t)l * 2048 * 2048, 2048, 2048, (bf16_t*)(ws + WS_WOUTT) + (size_t)l * 2048 * 2048, kb * 64, nb * 32, nb * 32, scr, lane); } }
        }
    }
}

DI void phaseA(const P& p, LAS unsigned char* lds, int layer) {
    TID_SETUP
    unsigned char* ws = p.ws;
    {
        const u32x4* src = (const u32x4*)((const bf16_t*)(ws + WS_WG) + (size_t)layer * 32768);
        for (int i = tid; i < 4096; i += 512) ((LAS u32x4*)lds)[i] = src[i];
    }
    __syncthreads();
    const float* modl = (const float*)(ws + WS_MOD) + (size_t)layer * 5 * 6144;
    const float* nw = p.in[I_NORMW] + layer * 2048;
    bf16_t* H = (bf16_t*)(ws + WS_H); float* gates = (float*)(ws + WS_GATES);
    const int gw = blockIdx.x * 8 + wave, NGW = gridDim.x * 8;
#define A_LOAD(dst, row) do { const int r_ = (row); \
        if (layer == 0) { const float* xr_ = r_ < 4096 ? p.in[I_XP] + (size_t)r_ * 2048 : p.in[I_XS] + (size_t)(r_ - 4096) * 2048; \
            _Pragma("unroll") for (int j = 0; j < 8; ++j) dst[j] = __builtin_nontemporal_load((const f32x4*)(xr_ + 4 * lane + 256 * j)); } \
        else { const bf16_t* xr_ = (const bf16_t*)(ws + WS_X1B) + (size_t)r_ * 2048; \
            _Pragma("unroll") for (int j = 0; j < 8; ++j) { const u32x2 w_ = *(const u32x2*)(xr_ + 4 * lane + 256 * j); \
                dst[j][0] = __uint_as_float(w_.x << 16); dst[j][1] = __uint_as_float(w_.x & 0xffff0000u); dst[j][2] = __uint_as_float(w_.y << 16); dst[j][3] = __uint_as_float(w_.y & 0xffff0000u); } } } while (0)
    for (int m = gw; m < NTOK; m += NGW) {
        f32x4 xv[8]; A_LOAD(xv, m);
        const int ci = m < 4096 ? 0 : 1 + ((m - 4096) >> 10);
        const float* shp = modl + ci * 6144; const float* scp = shp + 2048;
        float ss = 0.f;
#pragma unroll
        for (int j = 0; j < 8; ++j) ss += (xv[j][0] * xv[j][0] + xv[j][1] * xv[j][1]) + (xv[j][2] * xv[j][2] + xv[j][3] * xv[j][3]);
        const float rstd = rsqrtf(wave_sum(ss) * (1.f / 2048.f) + EPS);
        float ga[16];
#pragma unroll
        for (int n = 0; n < 16; ++n) ga[n] = 0.f;
#pragma unroll
        for (int j = 0; j < 8; ++j) { const int k = 4 * lane + 256 * j;
            const f32x4 w4 = *(const f32x4*)(nw + k), sh = *(const f32x4*)(shp + k), sc = *(const f32x4*)(scp + k);
            f32x4 v = xv[j] * rstd * w4 * (sc + 1.f) + sh;
            u32x2 o; o.x = pk2(v[0], v[1]); o.y = pk2(v[2], v[3]);
            *(u32x2*)(H + (size_t)m * 2048 + k) = o;
#pragma unroll
            for (int n = 0; n < 16; ++n) { const u32x2 w = *(const LAS u32x2*)(lds + (size_t)(n * 2048 + k) * 2);
                ga[n] = dot2bf(o.y, w.y, dot2bf(o.x, w.x, ga[n])); } }
        float mine = 0.f;
#pragma unroll
        for (int n = 0; n < 16; ++n) { const float s = wave_sum(ga[n]); mine = (lane == n) ? s : mine; }
        if (lane < 16) gates[(size_t)m * 16 + lane] = mine + p.in[I_BIF][layer * 16 + lane];
    }
#undef A_LOAD
    __syncthreads();
}

DI void phaseB2(const P& p, LAS unsigned char* lds, int layer) {
    TID_SETUP
    unsigned char* ws = p.ws;
    const bf16_t* Z = (const bf16_t*)(ws + WS_Z);
    LAS float* tile = (LAS float*)lds;
    LAS float* rope = (LAS float*)(lds + 36864);
    for (int i = tid; i < 1024; i += 512) ((LAS f32x4*)rope)[i] = ((const f32x4*)(ws + WS_ROPE))[i];
#define B2_DECODE(ITEM, tt, gi, LAT, b, t0, T, tokbase, kind, hd, zcol) \
        const int tt = (ITEM) / 2, gi = (ITEM) % 2; const bool LAT = tt >= 64; \
        const int b = LAT ? (tt - 64) >> 4 : tt >> 2, t0 = LAT ? ((tt - 64) & 15) * 64 : (tt & 3) * 64, T = LAT ? 1024 : 256; const int tokbase = tt * 64; \
        const int kind = gi < 2 ? 1 : gi < 6 ? 3 : gi < 10 ? 4 : gi < 14 ? 5 : 6; \
        const int hd = gi < 2 ? gi : gi < 6 ? gi - 2 : gi < 10 ? gi - 6 : gi < 14 ? gi - 10 : gi - 14; \
        const int zcol = (kind == 0 ? ZQ : kind == 1 ? ZK : kind == 2 ? ZV : kind == 3 ? ZMQ : kind == 4 ? ZMK : kind == 5 ? ZMV : ZFX) + hd * 128; (void)b; (void)T; (void)t0;
#define B2_LOAD(tokbase, zcol, kind, t0, T) do { \
        pv0 = *(const bf16x8*)(Z + (size_t)((tokbase) + (tid >> 4)) * NZ + (zcol) + (tid & 15) * 8); \
        pv1 = *(const bf16x8*)(Z + (size_t)((tokbase) + 32 + (tid >> 4)) * NZ + (zcol) + (tid & 15) * 8); \
        ph = (bf16x8){0, 0, 0, 0, 0, 0, 0, 0}; \
        if (((kind) == 3 || (kind) == 4) && tid < 32) { const int tl_ = (tid >> 4) ? 64 : -1; if ((t0) + tl_ >= 0 && (t0) + tl_ < (T)) ph = *(const bf16x8*)(Z + (size_t)((tokbase) + tl_) * NZ + (zcol) + (tid & 15) * 8); } } while (0)
    bf16x8 pv0, pv1, ph;
    if ((int)blockIdx.x < 128 * 2) { B2_DECODE((int)blockIdx.x, tt_, gi_, LAT_, b_, t0_, T_, tokbase_, kind_, hd_, zcol_) (void)hd_; B2_LOAD(tokbase_, zcol_, kind_, t0_, T_); }
    for (int item = blockIdx.x; item < 128 * 2; item += gridDim.x) {
        B2_DECODE(item, tt, gi, LAT, b, t0, T, tokbase, kind, hd, zcol)
        {   const int row = tid >> 4, c8 = (tid & 15) * 8;
#pragma unroll
            for (int jj = 0; jj < 8; ++jj) { tile[(row + 1) * 129 + c8 + jj] = bfs2f(pv0[jj]); tile[(row + 33) * 129 + c8 + jj] = bfs2f(pv1[jj]); }
            if ((kind == 3 || kind == 4) && tid < 32) { const int tl = (tid >> 4) ? 64 : -1;
#pragma unroll
                for (int jj = 0; jj < 8; ++jj) tile[(tl + 1) * 129 + c8 + jj] = bfs2f(ph[jj]); } }
        if (item + (int)gridDim.x < 128 * 2) { B2_DECODE(item + (int)gridDim.x, tt_, gi_, LAT_, b_, t0_, T_, tokbase_, kind_, hd_, zcol_) (void)hd_; B2_LOAD(tokbase_, zcol_, kind_, t0_, T_); }
        __syncthreads();
        if (kind <= 1) {
            const float* nwp = (kind == 0 ? p.in[I_QN] : p.in[I_KN]) + layer * 128;
            const int dA = lane < 32 ? lane : lane + 32, dB = dA + 32;
            const float wA = nwp[dA], wB = nwp[dB];
#pragma unroll
            for (int rr = 0; rr < 8; ++rr) { const int row = wave * 8 + rr;
                float xA = tile[(row + 1) * 129 + dA], xB = tile[(row + 1) * 129 + dB];
                const float rstd = rsqrtf(wave_sum(xA * xA + xB * xB) * (1.f / 128.f) + EPS);
                float yA = xA * rstd * wA, yB = xB * rstd * wB;
                if (LAT) { const int pos = lane < 32 ? (t0 >> 6) : row; const float c = rope[2 * (pos * 32 + (lane & 31))], s = rope[2 * (pos * 32 + (lane & 31)) + 1];
                    const float a = yA * c - yB * s, bb = yA * s + yB * c; yA = a; yB = bb; }
                tile[(row + 1) * 129 + dA] = yA; tile[(row + 1) * 129 + dB] = yB; }
            __syncthreads();
        } else if (kind == 3 || kind == 4) {
            const int cc0 = (kind == 3 ? 0 : 512) + hd * 128;
            const float* cw = p.in[I_CONVW] + (size_t)layer * 3 * 1024 + cc0; const float* cb = p.in[I_CONVB] + layer * 1024 + cc0;
            const int c = tid & 127; const float w0 = cw[c], w1 = cw[1024 + c], w2 = cw[2048 + c], bb = cb[c]; const float osc = kind == 4 ? 0.08838834764831845f : 1.f;
            float vals[16];
#pragma unroll
            for (int i = 0; i < 16; ++i) { const int row = (tid >> 7) + 4 * i; const float v = w0 * tile[row * 129 + c] + w1 * tile[(row + 1) * 129 + c] + w2 * tile[(row + 2) * 129 + c] + bb; vals[i] = silu_f(v) * osc; }
            __syncthreads();
#pragma unroll
            for (int i = 0; i < 16; ++i) { const int row = (tid >> 7) + 4 * i; tile[(row + 1) * 129 + c] = vals[i]; }
            __syncthreads();
        }
        if (kind <= 4) {
            bf16_t* dst;
            if (kind == 0) dst = (bf16_t*)(ws + WS_Q) + (LAT ? (size_t)4096 * 1024 : 0) + ((size_t)(b * 8 + hd) * T + t0) * 128;
            else if (kind == 1 || kind == 2) { bf16_t* base = (bf16_t*)(ws + (kind == 1 ? WS_K : WS_V));
                dst = LAT ? base + KC_ELEMS + (size_t)layer * KL_ELEMS + ((size_t)(b * 2 + hd) * 1536 + 512 + t0) * 128 : base + ((size_t)(b * 2 + hd) * 256 + t0) * 128; }
            else dst = (bf16_t*)(ws + (kind == 3 ? WS_MQ : WS_MK)) + (LAT ? (size_t)4096 * 512 : 0) + ((size_t)(b * 4 + hd) * T + t0) * 128;
#pragma unroll
            for (int i = 0; i < 2; ++i) { const int ch = tid + 512 * i, row = ch >> 4, c8 = (ch & 15) * 8; float v[8];
#pragma unroll
                for (int j = 0; j < 8; ++j) v[j] = tile[(row + 1) * 129 + c8 + j];
                *(bf16x8*)(dst + (size_t)row * 128 + c8) = pack8(v); }
        }
        if (kind >= 4) {
            bf16_t* dst = (bf16_t*)(ws + (kind == 4 ? WS_MKT : (kind == 5 ? WS_MVT : WS_XT))) + (LAT ? (size_t)4096 * 512 : 0) + (size_t)(b * 4 + hd) * 128 * T + t0;
#pragma unroll
            for (int i = 0; i < 2; ++i) { const int ch = tid + 512 * i, c = ch & 127, t8 = (ch >> 7) * 8; float v[8];
#pragma unroll
                for (int j = 0; j < 8; ++j) v[j] = tile[(t8 + j + 1) * 129 + c];
                *(bf16x8*)(dst + (size_t)c * T + t8) = pack8(v); }
        }
        if (!LAT && (kind == 1 || kind == 2)) {
            float* o = p.out + (kind == 1 ? O_NK : O_NV);
#pragma unroll
            for (int i = 0; i < 4; ++i) { const int ch = tid + 512 * i, row = ch >> 5, c4 = (ch & 31) * 4;
                f32x4 v; v[0] = tile[(row + 1) * 129 + c4]; v[1] = tile[(row + 1) * 129 + c4 + 1]; v[2] = tile[(row + 1) * 129 + c4 + 2]; v[3] = tile[(row + 1) * 129 + c4 + 3];
                *(f32x4*)(o + ((((size_t)b * 2 + layer) * 256 + t0 + row) * 2 + hd) * 128 + c4) = v; }
        }
        __syncthreads();
    }
}

DI float scan_add(float x, int lane, bool rev) {
#pragma unroll
    for (int o = 1; o < 64; o <<= 1) { const float v = rev ? __shfl_down(x, o) : __shfl_up(x, o); const bool ok = rev ? (lane + o < 64) : (lane >= o); if (ok) x += v; }
    return x;
}
DI float scan_max(float x, int lane, bool rev) {
#pragma unroll
    for (int o = 1; o < 64; o <<= 1) { const float v = rev ? __shfl_down(x, o) : __shfl_up(x, o); const bool ok = rev ? (lane + o < 64) : (lane >= o); if (ok) x = fmaxf(x, v); }
    return x;
}

DI att::s16x4 xtr(int addr) { att::s16x4 r; asm volatile("ds_read_b64_tr_b16 %0, %1" : "=&v"(r) : "v"(addr) : "memory"); return r; }
DI bf16x8 trfrag(int addr) {
    att::s16x4 l, h;
    asm volatile("ds_read_b64_tr_b16 %0, %2\n\tds_read_b64_tr_b16 %1, %2 offset:2048\n\ts_waitcnt lgkmcnt(0)" : "=&v"(l), "=&v"(h) : "v"(addr) : "memory");
    return (bf16x8){l[0], l[1], l[2], l[3], h[0], h[1], h[2], h[3]}; }
DI void trfrag3(bf16x8& f0, bf16x8& f1, bf16x8& f2, int a0, int a1, int a2) {
    att::s16x4 l0, h0, l1, h1, l2, h2;
    asm volatile("ds_read_b64_tr_b16 %0, %6\n\tds_read_b64_tr_b16 %1, %6 offset:2048\n\tds_read_b64_tr_b16 %2, %7\n\tds_read_b64_tr_b16 %3, %7 offset:2048\n\tds_read_b64_tr_b16 %4, %8\n\tds_read_b64_tr_b16 %5, %8 offset:2048\n\ts_waitcnt lgkmcnt(0)"
                 : "=&v"(l0), "=&v"(h0), "=&v"(l1), "=&v"(h1), "=&v"(l2), "=&v"(h2) : "v"(a0), "v"(a1), "v"(a2) : "memory");
    f0 = (bf16x8){l0[0], l0[1], l0[2], l0[3], h0[0], h0[1], h0[2], h0[3]}; f1 = (bf16x8){l1[0], l1[1], l1[2], l1[3], h1[0], h1[1], h1[2], h1[3]}; f2 = (bf16x8){l2[0], l2[1], l2[2], l2[3], h2[0], h2[1], h2[2], h2[3]}; }
DI void trfrag2(bf16x8& f0, bf16x8& f1, int a0, int a1) {
    att::s16x4 l0, h0, l1, h1;
    asm volatile("ds_read_b64_tr_b16 %0, %4\n\tds_read_b64_tr_b16 %1, %4 offset:2048\n\tds_read_b64_tr_b16 %2, %5\n\tds_read_b64_tr_b16 %3, %5 offset:2048\n\ts_waitcnt lgkmcnt(0)"
                 : "=&v"(l0), "=&v"(h0), "=&v"(l1), "=&v"(h1) : "v"(a0), "v"(a1) : "memory");
    f0 = (bf16x8){l0[0], l0[1], l0[2], l0[3], h0[0], h0[1], h0[2], h0[3]}; f1 = (bf16x8){l1[0], l1[1], l1[2], l1[3], h1[0], h1[1], h1[2], h1[3]}; }
struct Conv8 { f32x4 w[3][2]; f32x4 b[2]; };
DI void conv8_load(Conv8& c, const float* cw, const float* cb) {
#pragma unroll
    for (int j = 0; j < 3; ++j) { c.w[j][0] = *(const f32x4*)(cw + j * 1024); c.w[j][1] = *(const f32x4*)(cw + j * 1024 + 4); }
    c.b[0] = *(const f32x4*)cb; c.b[1] = *(const f32x4*)(cb + 4);
}
DI void conv8_apply(float (&o)[8], const Conv8& c, const bf16_t* zrow, bool has_prev, bool has_next, float osc) {
    const bf16x8 z8 = {0, 0, 0, 0, 0, 0, 0, 0};
    const bf16x8 x1 = *(const bf16x8*)zrow; bf16x8 x0 = z8, x2 = z8;
    if (has_prev) x0 = *(const bf16x8*)(zrow - NZ);
    if (has_next) x2 = *(const bf16x8*)(zrow + NZ);
#pragma unroll
    for (int j = 0; j < 8; ++j) { const float v = c.w[0][j >> 2][j & 3] * bfs2f(x0[j]) + c.w[1][j >> 2][j & 3] * bfs2f(x1[j]) + c.w[2][j >> 2][j & 3] * bfs2f(x2[j]) + c.b[j >> 2][j & 3]; o[j] = silu_f(v) * osc; }
}
template <bool LAT>
DI void gate_scan_block(const P& p, LAS unsigned char* lds, int layer, int b, int head, int dir) {
    TID_SETUP
    constexpr int T = LAT ? 1024 : 256, NCH = T / 64;
    unsigned char* ws = p.ws;
    const int tok0 = LAT ? 4096 + b * 1024 : b * 256;
    const int sidx = ((b * 2 + layer) * 2 + dir) * 4 + head;
    const float m0 = LAT ? p.in[I_SM][sidx] : 0.f;
    float* GS = (float*)(ws + WS_GS) + (size_t)(dir * 4 + head) * NTOK;
    float* DEC = (float*)(ws + WS_DEC) + (dir * 4 + head) * 128;
    const float* gates = (const float*)(ws + WS_GATES);
    LAS float* bl_l = (LAS float*)lds; LAS float* am_l = bl_l + 16;
    float a_r[2], bc_r[2], am_r[2];
#pragma unroll
    for (int q = 0; q < 2; ++q) { const int it = wave + 8 * q; a_r[q] = 0.f; bc_r[q] = 0.f; am_r[q] = 0.f;
        if (it < NCH) { const int cj = dir ? NCH - 1 - it : it; const float* gr = gates + (size_t)(tok0 + cj * 64 + lane) * 16;
            const float giv = gr[(dir ? 8 : 0) + head], gfv = gr[(dir ? 12 : 4) + head];
            const float lf = fminf(gfv, 0.f) - log1pf(expf(-fabsf(gfv)));
            const float bc = scan_add(lf, lane, dir != 0); const float a = giv - bc; const float am = scan_max(a, lane, dir != 0);
            const int last = dir ? 0 : 63;
            const float blast = __shfl(bc, last), amall = __shfl(am, last);
            if (lane == 0) { bl_l[it] = blast; am_l[it] = amall; }
            a_r[q] = a; bc_r[q] = bc; am_r[q] = am; } }
    __syncthreads();
#pragma unroll
    for (int q = 0; q < 2; ++q) { const int it = wave + 8 * q;
        if (it < NCH) { const int cj = dir ? NCH - 1 - it : it; const int tok = tok0 + cj * 64 + lane;
            float m = m0; for (int k = 0; k < it; ++k) m = bl_l[k] + fmaxf(m, am_l[k]);
            const float M = fmaxf(m, am_r[q]), Mall = fmaxf(m, am_l[it]);
            GS[tok] = a_r[q]; GS[65536 + tok] = M; GS[2 * 65536 + tok] = expf(m - M); GS[3 * 65536 + tok] = expf(-(bc_r[q] + M)); GS[4 * 65536 + tok] = expf(a_r[q] - Mall);
            if (lane == 0) DEC[(tok0 >> 6) + cj] = expf(m - Mall);
            if (!LAT && it == NCH - 1 && lane == 0) p.out[O_NM + sidx] = bl_l[it] + Mall; } }
    __syncthreads();
}

DI void gate_scan_phase(const P& p, LAS unsigned char* lds, int layer) {
    for (int s = blockIdx.x; s < 160; s += gridDim.x) {
        if (s < 128) gate_scan_block<false>(p, lds, layer, s >> 3, (s >> 1) & 3, s & 1);
        else gate_scan_block<true>(p, lds, layer, (s - 128) >> 3, (s >> 1) & 3, s & 1); }
}

struct M1Rows { bf16x8 v[2], k0[2], k1[2], k2[2]; float w0[2], w1[2]; };
DI void m1_rows_load(M1Rows& R, const bf16_t* Z, const float* WK0, const float* WK1, int t0, int T, int tid) {
    const bf16x8 z8 = {0, 0, 0, 0, 0, 0, 0, 0}; const int c8 = (tid & 15) * 8;
#pragma unroll
    for (int i = 0; i < 2; ++i) { const int row = (tid >> 4) + 32 * i; const bf16_t* zr = Z + (size_t)row * NZ;
        R.v[i] = *(const bf16x8*)(zr + ZMV + c8); R.k1[i] = *(const bf16x8*)(zr + ZMK + c8);
        R.k0[i] = (t0 + row > 0) ? *(const bf16x8*)(zr - NZ + ZMK + c8) : z8; R.k2[i] = (t0 + row < T - 1) ? *(const bf16x8*)(zr + NZ + ZMK + c8) : z8;
        R.w0[i] = WK0[row]; R.w1[i] = WK1[row]; }
}
DI void m1_group(const P& p, LAS unsigned char* lds, int layer, int gidx) {
    TID_SETUP
    unsigned char* ws = p.ws;
    const int id0 = gidx * 4; const bool LAT = id0 >= 256; const int u0 = LAT ? id0 - 256 : id0;
    const int b = LAT ? u0 >> 6 : u0 >> 4, head = LAT ? (u0 >> 4) & 3 : (u0 >> 2) & 3, chunk0 = LAT ? u0 & 15 : u0 & 3;
    const int T = LAT ? 1024 : 256, tok0 = LAT ? 4096 + b * 1024 : b * 256;
    const int c8 = (tid & 15) * 8;
    Conv8 cv; conv8_load(cv, p.in[I_CONVW] + (size_t)layer * 3072 + 512 + head * 128 + c8, p.in[I_CONVB] + layer * 1024 + 512 + head * 128 + c8);
    const bf16_t* Zh = (const bf16_t*)(ws + WS_Z) + (size_t)tok0 * NZ + head * 128;
    const float* WKh = (const float*)(ws + WS_GS) + (size_t)4 * 65536 + (size_t)head * NTOK + tok0;
    const int r = lane & 31, hl = lane >> 5, eb4 = wave >> 1, dh = wave & 1;
    const int vb = (int)(unsigned)(size_t)lds + att::v_rd_base(lane);
    const bf16x8 ones = {0x3F80, 0x3F80, 0x3F80, 0x3F80, 0x3F80, 0x3F80, 0x3F80, 0x3F80};
    M1Rows R; { const int t0 = chunk0 * 64; m1_rows_load(R, Zh + (size_t)t0 * NZ, WKh + t0, WKh + (size_t)4 * NTOK + t0, t0, T, tid); }
#pragma unroll 1
    for (int q = 0; q < 4; ++q) {
        const int t0 = (chunk0 + q) * 64;
#pragma unroll
        for (int i = 0; i < 2; ++i) { const int row = (tid >> 4) + 32 * i; const int st = att::v_st(row, c8);
            *(LAS bf16x8*)(lds + st) = R.v[i];
            float kv[8], k2[8];
#pragma unroll
            for (int e = 0; e < 8; ++e) { const float cvv = cv.w[0][e >> 2][e & 3] * bfs2f(R.k0[i][e]) + cv.w[1][e >> 2][e & 3] * bfs2f(R.k1[i][e]) + cv.w[2][e >> 2][e & 3] * bfs2f(R.k2[i][e]) + cv.b[e >> 2][e & 3];
                const float kk = silu_f(cvv) * 0.08838834764831845f; kv[e] = kk * R.w0[i]; k2[e] = kk * R.w1[i]; }
            *(LAS bf16x8*)(lds + 16384 + st) = pack8(kv); *(LAS bf16x8*)(lds + 32768 + st) = pack8(k2); }
        __syncthreads();
        if (q < 3) { const int t1 = t0 + 64; m1_rows_load(R, Zh + (size_t)t1 * NZ, WKh + t1, WKh + (size_t)4 * NTOK + t1, t1, T, tid); }
#pragma unroll 1
        for (int dir = 0; dir < 2; ++dir) {
            const int kb = vb + 16384 + dir * 16384;
            const int cd = (dir * 4 + head) * 128 + ((tok0 + t0) >> 6);
            f32x16 acc[2], accn[2];
#pragma unroll
            for (int i = 0; i < 16; ++i) { acc[0][i] = 0.f; acc[1][i] = 0.f; accn[0][i] = 0.f; accn[1][i] = 0.f; }
#pragma unroll
            for (int ks = 0; ks < 4; ++ks) {
                bf16x8 vf, kf[2]; trfrag3(vf, kf[0], kf[1], vb + eb4 * 512 + ks * 4096, kb + (2 * dh) * 512 + ks * 4096, kb + (2 * dh + 1) * 512 + ks * 4096);
#pragma unroll
                for (int db = 0; db < 2; ++db) { acc[db] = MFMA32(vf, kf[db], acc[db]);
                    if (eb4 == 0) accn[db] = MFMA32(ones, kf[db], accn[db]); }
            }
            bf16_t* U = (bf16_t*)(ws + WS_U) + (size_t)cd * 16384;
#pragma unroll
            for (int db = 0; db < 2; ++db)
#pragma unroll
                for (int i = 0; i < 16; ++i) U[(32 * eb4 + crow(i, hl)) * 128 + 64 * dh + 32 * db + r] = f2bf(acc[db][i]);
            if (eb4 == 0 && hl == 0) { float* UN = (float*)(ws + WS_UN) + (size_t)cd * 128 + 64 * dh + r; UN[0] = accn[0][0]; UN[32] = accn[1][0]; }
        }
        __syncthreads();
    }
}

template <bool LAT>
DI void m2_unit(const P& p, int layer, int b, int head, int dir, int eg) {
    TID_SETUP
    constexpr int T = LAT ? 1024 : 256, NCH = T / 64;
    unsigned char* ws = p.ws;
    const int tok0 = LAT ? 4096 + b * 1024 : b * 256;
    const int sidx = ((b * 2 + layer) * 2 + dir) * 4 + head;
    const int cdbase = (dir * 4 + head) * 128 + (tok0 >> 6);
    const float* DEC = (const float*)(ws + WS_DEC);
    const int ebase = eg * 2048 + tid;
    float uv[NCH][4], dec[NCH], un[NCH];
#pragma unroll
    for (int it = 0; it < NCH; ++it) { const int cd = cdbase + (dir ? NCH - 1 - it : it); const bf16_t* U = (const bf16_t*)(ws + WS_U) + (size_t)cd * 16384 + ebase;
        dec[it] = DEC[cd];
#pragma unroll
        for (int i = 0; i < 4; ++i) uv[it][i] = bf2f(U[512 * i]);
        un[it] = (eg == 0 && tid < 128) ? ((const float*)(ws + WS_UN))[(size_t)cd * 128 + tid] : 0.f; }
    float C[4];
#pragma unroll
    for (int i = 0; i < 4; ++i) { const int idx = ebase + 512 * i, e = idx >> 7, d = idx & 127; C[i] = LAT ? p.in[I_SC][(size_t)sidx * 16384 + d * 128 + e] : 0.f; }
    float n = 0.f; if (LAT && eg == 0 && tid < 128) n = p.in[I_SN][sidx * 128 + tid];
#pragma unroll
    for (int it = 0; it < NCH; ++it) { const int cd = cdbase + (dir ? NCH - 1 - it : it);
        bf16_t* CJ = (bf16_t*)(ws + WS_CJ) + (size_t)cd * 16384 + ebase;
#pragma unroll
        for (int i = 0; i < 4; ++i) { CJ[512 * i] = f2bf(C[i]); C[i] = dec[it] * C[i] + uv[it][i]; }
        if (eg == 0 && tid < 128) { ((float*)(ws + WS_NJ))[(size_t)cd * 128 + tid] = n; n = dec[it] * n + un[it]; } }
    if (!LAT) {
#pragma unroll
        for (int i = 0; i < 4; ++i) { const int idx = ebase + 512 * i, e = idx >> 7, d = idx & 127; p.out[O_NC + (size_t)sidx * 16384 + d * 128 + e] = C[i]; }
        if (eg == 0 && tid < 128) p.out[O_NN + (size_t)sidx * 128 + tid] = n;
    }
}

template <bool LAT> struct M2Regs { bf16x8 uv[(LAT ? 16 : 4)]; float dec[(LAT ? 16 : 4)]; float un[(LAT ? 16 : 4)]; };
template <bool LAT>
DI void m2_load(const P& p, M2Regs<LAT>& R, int b, int head, int dir, int eg, int tid) {
    constexpr int NCH = LAT ? 16 : 4;
    unsigned char* ws = p.ws;
    const int tok0 = LAT ? 4096 + b * 1024 : b * 256;
    const int cdbase = (dir * 4 + head) * 128 + (tok0 >> 6);
    const int ebase = eg * 4096 + tid * 8;
#pragma unroll
    for (int it = 0; it < NCH; ++it) { const int cd = cdbase + (dir ? NCH - 1 - it : it);
        R.dec[it] = ((const float*)(ws + WS_DEC))[cd];
        R.uv[it] = __builtin_nontemporal_load((const bf16x8*)((const bf16_t*)(ws + WS_U) + (size_t)cd * 16384 + ebase));
        R.un[it] = (eg == 0 && tid < 128) ? ((const float*)(ws + WS_UN))[(size_t)cd * 128 + tid] : 0.f; }
}
template <bool LAT>
DI void m2_run(const P& p, const M2Regs<LAT>& R, int layer, int b, int head, int dir, int eg, int tid) {
    constexpr int NCH = LAT ? 16 : 4;
    unsigned char* ws = p.ws;
    const int tok0 = LAT ? 4096 + b * 1024 : b * 256;
    const int sidx = ((b * 2 + layer) * 2 + dir) * 4 + head;
    const int cdbase = (dir * 4 + head) * 128 + (tok0 >> 6);
    const int ebase = eg * 4096 + tid * 8, e = ebase >> 7, d0 = ebase & 127;
    float C[8];
#pragma unroll
    for (int i = 0; i < 8; ++i) C[i] = LAT ? p.in[I_SC][(size_t)sidx * 16384 + (d0 + i) * 128 + e] : 0.f;
    float n = 0.f; if (LAT && eg == 0 && tid < 128) n = p.in[I_SN][sidx * 128 + tid];
#pragma unroll
    for (int it = 0; it < NCH; ++it) { const int cd = cdbase + (dir ? NCH - 1 - it : it);
        *(bf16x8*)((bf16_t*)(ws + WS_CJ) + (size_t)cd * 16384 + ebase) = pack8(C);
#pragma unroll
        for (int i = 0; i < 8; ++i) C[i] = R.dec[it] * C[i] + bfs2f(R.uv[it][i]);
        if (eg == 0 && tid < 128) { ((float*)(ws + WS_NJ))[(size_t)cd * 128 + tid] = n; n = R.dec[it] * n + R.un[it]; } }
    if (!LAT) {
#pragma unroll
        for (int i = 0; i < 8; ++i) __builtin_nontemporal_store(C[i], &p.out[O_NC + (size_t)sidx * 16384 + (d0 + i) * 128 + e]);
        if (eg == 0 && tid < 128) p.out[O_NN + (size_t)sidx * 128 + tid] = n;
    }
}
DI void m2_block(const P& p, int layer, int slot) {
    TID_SETUP
    M2Regs<false> Rc[2]; M2Regs<true> Rl;
#pragma unroll
    for (int k = 0; k < 2; ++k) { const int u = slot + 256 * k, s = u >> 2; m2_load<false>(p, Rc[k], s >> 3, (s >> 1) & 3, s & 1, u & 3, tid); }
    if (slot < 128) { const int s = slot >> 2; m2_load<true>(p, Rl, s >> 3, (s >> 1) & 3, s & 1, slot & 3, tid); }
#pragma unroll
    for (int k = 0; k < 2; ++k) { const int u = slot + 256 * k, s = u >> 2; m2_run<false>(p, Rc[k], layer, s >> 3, (s >> 1) & 3, s & 1, u & 3, tid); }
    if (slot < 128) { const int s = slot >> 2; m2_run<true>(p, Rl, layer, s >> 3, (s >> 1) & 3, s & 1, slot & 3, tid); }
}

DI void m3_task(const P& p, LAS unsigned char* lds, int layer, int id) {
    TID_SETUP
    unsigned char* ws = p.ws;
    const bool LAT = id >= 256; const int u = LAT ? id - 256 : id;
    const int b = LAT ? u >> 6 : u >> 4, head = LAT ? (u >> 4) & 3 : (u >> 2) & 3, chunk = LAT ? u & 15 : u & 3;
    const int T = LAT ? 1024 : 256, tok0 = LAT ? 4096 + b * 1024 : b * 256, t0 = chunk * 64;
    const int dir = wave >> 2, w4 = wave & 3, td = tid & 255;
    const int cd = (dir * 4 + head) * 128 + ((tok0 + t0) >> 6);
    const float* GS = (const float*)(ws + WS_GS) + (size_t)(dir * 4 + head) * NTOK + tok0 + t0;
    LAS bf16_t* Ql = (LAS bf16_t*)(lds + 98304); LAS bf16_t* Kl = (LAS bf16_t*)(lds + 98304 + 17408); LAS unsigned char* Vimg = lds + 98304 + 34816;
    {   const bf16_t* Zc = (const bf16_t*)(ws + WS_Z) + (size_t)(tok0 + t0) * NZ + head * 128; const int c8 = (tid & 15) * 8;
        Conv8 cq, ck; conv8_load(cq, p.in[I_CONVW] + (size_t)layer * 3072 + head * 128 + c8, p.in[I_CONVB] + layer * 1024 + head * 128 + c8);
        conv8_load(ck, p.in[I_CONVW] + (size_t)layer * 3072 + 512 + head * 128 + c8, p.in[I_CONVB] + layer * 1024 + 512 + head * 128 + c8);
#pragma unroll
        for (int i = 0; i < 2; ++i) { const int row = (tid >> 4) + 32 * i; const bool hp = t0 + row > 0, hn = t0 + row < T - 1; float v8[8];
            conv8_apply(v8, cq, Zc + (size_t)row * NZ + ZMQ + c8, hp, hn, 1.f); *(LAS bf16x8*)(Ql + row * 136 + c8) = pack8(v8);
            conv8_apply(v8, ck, Zc + (size_t)row * NZ + ZMK + c8, hp, hn, 0.08838834764831845f); *(LAS bf16x8*)(Kl + row * 136 + c8) = pack8(v8);
            *(LAS bf16x8*)(Vimg + att::v_st(row, c8)) = __builtin_nontemporal_load((const bf16x8*)(Zc + (size_t)row * NZ + ZMV + c8)); } }
    LAS unsigned char* L = lds + dir * 49152;
    LAS bf16_t* CTl = (LAS bf16_t*)L; LAS bf16_t* Sl = (LAS bf16_t*)(L + 34816); LAS float* vec = (LAS float*)(L + 44032);
    LAS float* Hl = (LAS float*)L;
    LAS float *a_l = vec, *M_l = vec + 64, *wi_l = vec + 128, *emr_l = vec + 192, *dinv_l = vec + 320, *qn_l = vec + 384, *n_l = vec + 640;
    const int r = lane & 31, hl = lane >> 5, wi = w4 >> 1, wj = w4 & 1;
    if (td < 64) { a_l[td] = GS[td]; M_l[td] = GS[65536 + td]; wi_l[td] = GS[2 * 65536 + td]; emr_l[td] = GS[3 * 65536 + td]; }
    if (td >= 128) n_l[td - 128] = ((const float*)(ws + WS_NJ))[(size_t)cd * 128 + td - 128];
    {   const bf16_t* CJ = (const bf16_t*)(ws + WS_CJ) + (size_t)cd * 16384;
#pragma unroll
        for (int i = 0; i < 8; ++i) { const int ch = td + 256 * i, e = ch >> 4, d8 = (ch & 15) * 8; *(LAS bf16x8*)(CTl + e * 136 + d8) = __builtin_nontemporal_load((const bf16x8*)(CJ + e * 128 + d8)); } }
    __syncthreads();
    bf16x8 qf[8];
#pragma unroll
    for (int ks = 0; ks < 8; ++ks) qf[ks] = *(const LAS bf16x8*)(Ql + (32 * wi + r) * 136 + 16 * ks + 8 * hl);
    {   const int pp = td & 63, part = td >> 6; const LAS bf16_t* qp = Ql + pp * 136 + 32 * part; float s = 0.f;
#pragma unroll
        for (int c = 0; c < 4; ++c) { const bf16x8 v = *(const LAS bf16x8*)(qp + 8 * c);
#pragma unroll
            for (int j = 0; j < 8; ++j) s += bfs2f(v[j]) * n_l[32 * part + 8 * c + j]; }
        qn_l[part * 64 + pp] = s; }
    {   f32x16 sacc;
#pragma unroll
        for (int i = 0; i < 16; ++i) sacc[i] = 0.f;
#pragma unroll
        for (int ks = 0; ks < 8; ++ks) { const bf16x8 kf = *(const LAS bf16x8*)(Kl + (32 * wj + r) * 136 + 16 * ks + 8 * hl); sacc = MFMA32(qf[ks], kf, sacc); }
        const int s_ = 32 * wj + r; const float as = a_l[s_];
#pragma unroll
        for (int i = 0; i < 16; ++i) { const int pr = 32 * wi + crow(i, hl); const bool valid = dir ? (s_ >= pr) : (s_ <= pr);
            const float v = valid ? sacc[i] * __expf(as - M_l[pr]) : 0.f;
            Sl[pr * 72 + s_] = f2bf(v); } }
    __syncthreads();
    if (w4 == 0) { float rs = 0.f;
#pragma unroll
        for (int c = 0; c < 8; ++c) { const bf16x8 v = *(const LAS bf16x8*)(Sl + lane * 72 + 8 * c);
#pragma unroll
            for (int j = 0; j < 8; ++j) rs += bfs2f(v[j]); }
        const float qn = (qn_l[lane] + qn_l[64 + lane]) + (qn_l[128 + lane] + qn_l[192 + lane]);
        const float den = wi_l[lane] * qn + rs; dinv_l[lane] = 1.f / fmaxf(fabsf(den), emr_l[lane]); }
    f32x16 nacc[2];
#pragma unroll
    for (int i = 0; i < 16; ++i) { nacc[0][i] = 0.f; nacc[1][i] = 0.f; }
#pragma unroll
    for (int ks = 0; ks < 8; ++ks)
#pragma unroll
        for (int eb = 0; eb < 2; ++eb) { const bf16x8 cf = *(const LAS bf16x8*)(CTl + (64 * wj + 32 * eb + r) * 136 + 16 * ks + 8 * hl); nacc[eb] = MFMA32(qf[ks], cf, nacc[eb]); }
#pragma unroll
    for (int i = 0; i < 16; ++i) { const float w = wi_l[32 * wi + crow(i, hl)]; nacc[0][i] *= w; nacc[1][i] *= w; }
#pragma unroll
    for (int ks = 0; ks < 4; ++ks) { const bf16x8 sf = *(const LAS bf16x8*)(Sl + (32 * wi + r) * 72 + 16 * ks + 8 * hl);
        bf16x8 vf[2]; { const int va = (int)(unsigned)(size_t)Vimg + att::v_rd_base(lane) + (2 * wj) * 512 + ks * 4096; trfrag2(vf[0], vf[1], va, va + 512); }
#pragma unroll
        for (int eb = 0; eb < 2; ++eb) nacc[eb] = MFMA32(sf, vf[eb], nacc[eb]); }
    __syncthreads();
#pragma unroll
    for (int i = 0; i < 16; ++i) { const int pr = 32 * wi + crow(i, hl); const float di = dinv_l[pr];
        Hl[pr * 132 + 64 * wj + r] = nacc[0][i] * di; Hl[pr * 132 + 64 * wj + 32 + r] = nacc[1][i] * di; }
    __syncthreads();
    {   const bf16_t* Z = (const bf16_t*)(ws + WS_Z); bf16_t* mix = (bf16_t*)(ws + WS_H);
        const float* mln = p.in[I_MLN] + layer * 512 + head * 128; const float wa = mln[lane], wb = mln[lane + 64];
        LAS float* H0 = (LAS float*)lds; LAS float* H1 = (LAS float*)(lds + 49152);
        float xa[8], xb[8], moa[8], mob[8], mga[8], mgb[8];
#pragma unroll
        for (int rr = 0; rr < 8; ++rr) { const int pr = wave * 8 + rr, tok = tok0 + t0 + pr;
            xa[rr] = H0[pr * 132 + lane] + H1[pr * 132 + lane]; xb[rr] = H0[pr * 132 + 64 + lane] + H1[pr * 132 + 64 + lane];
            const bf16_t* zr = Z + (size_t)tok * NZ + head * 128;
            moa[rr] = bf2f(zr[ZMO + lane]); mob[rr] = bf2f(zr[ZMO + lane + 64]); mga[rr] = bf2f(zr[ZMG + lane]); mgb[rr] = bf2f(zr[ZMG + lane + 64]); }
#pragma unroll
        for (int rr = 0; rr < 8; ++rr) { const int pr = wave * 8 + rr, tok = tok0 + t0 + pr;
            const float rstd = rsqrtf(wave_sum(xa[rr] * xa[rr] + xb[rr] * xb[rr]) * (1.f / 128.f) + EPS);
            bf16_t* mr = mix + (size_t)tok * 2048 + 1024 + head * 128;
            mr[lane] = f2bf(xa[rr] * rstd * wa * sigm_f(moa[rr]) * silu_f(mga[rr])); mr[lane + 64] = f2bf(xb[rr] * rstd * wb * sigm_f(mob[rr]) * silu_f(mgb[rr])); }
    }
    __syncthreads();
}

DI void tile_ld(bf16x8 (&rg)[2], const bf16_t* src, int ld, int tid) {
#pragma unroll
    for (int i = 0; i < 2; ++i) { const int ch = tid + 512 * i, row = ch >> 3, c8 = (ch & 7) * 8; rg[i] = *(const bf16x8*)(src + (size_t)row * ld + c8); }
}
DI void tile_st(LAS bf16_t* dst, const bf16x8 (&rg)[2], int tid) {
#pragma unroll
    for (int i = 0; i < 2; ++i) { const int ch = tid + 512 * i, row = ch >> 3, c8 = (ch & 7) * 8; *(LAS bf16x8*)(dst + row * 72 + c8) = rg[i]; }
}

template <bool LAT>
DI void fourier_task(const P& p, LAS unsigned char* lds, int layer, int b, int g, int tile) {
    TID_SETUP
    constexpr int T = LAT ? 1024 : 256, NKT = T / 64;
    unsigned char* ws = p.ws;
    const bf16_t* DC = (const bf16_t*)(ws + (LAT ? WS_DFTL : WS_DFTC)) + (size_t)tile * 128 * T; const bf16_t* DS = DC + (size_t)T * T;
    const bf16_t* XZ = (const bf16_t*)(ws + WS_Z) + (size_t)(LAT ? 4096 + b * 1024 : b * 256) * NZ + ZFX + g * 128;
    const int wr = wave >> 1, wc = wave & 1, r = lane & 31, hl = lane >> 5;
    const int xs0 = att::v_st(tid >> 4, (tid & 15) * 8), xs1 = att::v_st(32 + (tid >> 4), (tid & 15) * 8);
    const size_t xg0 = (size_t)(tid >> 4) * NZ + (tid & 15) * 8;
    f32x16 aP[2], aQ[2];
#pragma unroll
    for (int i = 0; i < 16; ++i) { aP[0][i] = 0.f; aP[1][i] = 0.f; aQ[0][i] = 0.f; aQ[1][i] = 0.f; }
    const bf16_t* CS = (const bf16_t*)(ws + WS_CSW) + (size_t)(layer * 4 + g) * 128 * 256;
    bf16x8 csr[8];
#pragma unroll
    for (int i = 0; i < 8; ++i) { const int ch = tid + 512 * i; csr[i] = *(const bf16x8*)(CS + (size_t)(ch >> 5) * 256 + (ch & 31) * 8); }
    bf16x8 rcA[2], rsA[2], rxA[2], rcB[2], rsB[2], rxB[2];
#define F_LD(S, kt_) do { tile_ld(rc##S, DC + (kt_) * 64, T, tid); tile_ld(rs##S, DS + (kt_) * 64, T, tid); \
        rx##S[0] = __builtin_nontemporal_load((const bf16x8*)(XZ + (size_t)(kt_) * 64 * NZ + xg0)); rx##S[1] = __builtin_nontemporal_load((const bf16x8*)(XZ + (size_t)((kt_) * 64 + 32) * NZ + xg0)); } while (0)
#define F_ST(S, buf_) do { LAS unsigned char* nb_ = lds + (buf_) * 55296; tile_st((LAS bf16_t*)nb_, rc##S, tid); tile_st((LAS bf16_t*)(nb_ + 18432), rs##S, tid); *(LAS bf16x8*)(nb_ + 36864 + xs0) = rx##S[0]; *(LAS bf16x8*)(nb_ + 36864 + xs1) = rx##S[1]; } while (0)
#define F_MMA(buf_) do { LAS unsigned char* cur = lds + (buf_) * 55296; \
        const LAS bf16_t* lc = (const LAS bf16_t*)cur + (32 * wr + r) * 72 + 8 * hl; const LAS bf16_t* ls = lc + 9216; \
        const int xb_ = (int)(unsigned)(size_t)(cur + 36864) + xrd; \
        _Pragma("unroll") for (int ks = 0; ks < 4; ++ks) { \
            const bf16x8 fc = *(const LAS bf16x8*)(lc + 16 * ks), fs = *(const LAS bf16x8*)(ls + 16 * ks); \
            bf16x8 x0, x1; trfrag2(x0, x1, xb_ + ks * 4096, xb_ + 512 + ks * 4096); \
            __builtin_amdgcn_s_setprio(1); aP[0] = MFMA32(fc, x0, aP[0]); aP[1] = MFMA32(fc, x1, aP[1]); aQ[0] = MFMA32(fs, x0, aQ[0]); aQ[1] = MFMA32(fs, x1, aQ[1]); __builtin_amdgcn_s_setprio(0); } } while (0)
    const int xrd = att::v_rd_base(lane) + wc * 1024;
    F_LD(B, 0); F_ST(B, 0); F_LD(A, 1); __syncthreads();
#pragma unroll 1
    for (int kt = 0; kt < NKT; kt += 2) {
        if (kt + 2 < NKT) F_LD(B, kt + 2);
        F_MMA(0);
        F_ST(A, 1);
        __syncthreads();
        if (kt + 3 < NKT) F_LD(A, kt + 3);
        F_MMA(1);
        if (kt + 2 < NKT) F_ST(B, 0);
        __syncthreads();
    }
#undef F_LD
#undef F_ST
#undef F_MMA
    LAS bf16_t* PQ = (LAS bf16_t*)lds;
#pragma unroll
    for (int cb = 0; cb < 2; ++cb)
#pragma unroll
        for (int i = 0; i < 16; ++i) { const int row = 32 * wr + crow(i, hl);
            PQ[row * 264 + 64 * wc + 32 * cb + r] = f2bf(aP[cb][i]); PQ[row * 264 + 128 + 64 * wc + 32 * cb + r] = f2bf(aQ[cb][i]); }
    LAS bf16_t* CSl = (LAS bf16_t*)(lds + 67584);
#pragma unroll
    for (int i = 0; i < 8; ++i) { const int ch = tid + 512 * i; *(LAS bf16x8*)(CSl + (ch >> 5) * 264 + (ch & 31) * 8) = csr[i]; }
    __syncthreads();
    f32x16 o[2];
#pragma unroll
    for (int i = 0; i < 16; ++i) { o[0][i] = 0.f; o[1][i] = 0.f; }
#pragma unroll
    for (int ks = 0; ks < 16; ++ks) { const bf16x8 af = *(const LAS bf16x8*)(PQ + (32 * wr + r) * 264 + 16 * ks + 8 * hl);
#pragma unroll
        for (int db = 0; db < 2; ++db) { const bf16x8 bfr = *(const LAS bf16x8*)(CSl + (64 * wc + 32 * db + r) * 264 + 16 * ks + 8 * hl); o[db] = MFMA32(af, bfr, o[db]); } }
    const bf16_t* Z = (const bf16_t*)(ws + WS_Z); bf16_t* mix = (bf16_t*)(ws + WS_H);
    const int tokb = (LAT ? 4096 + b * 1024 : b * 256) + tile * 128 + 32 * wr;
#pragma unroll
    for (int i = 0; i < 16; ++i) { const int tok = tokb + crow(i, hl);
#pragma unroll
        for (int db = 0; db < 2; ++db) { const int d = 64 * wc + 32 * db + r; const float fg = bf2f(Z[(size_t)tok * NZ + ZFG + g * 128 + d]);
            mix[(size_t)tok * 2048 + 1536 + g * 128 + d] = f2bf(o[db][i] * silu_f(fg)); } }
    __syncthreads();
}

DI void attn_task(const P& p, unsigned char* lds_generic, int layer, bool LAT, int b, int h, int qb) {
    unsigned char* ws = p.ws;
    const int kvh = h >> 2;
    const int tok0 = LAT ? 4096 + b * 1024 : b * 256, tok = tok0 + qb * 256;
    const bf16_t* Z = (const bf16_t*)(ws + WS_Z);
    const bf16_t* Q = Z + (size_t)tok * NZ + ZQ + h * 128;
    const size_t koff = LAT ? (size_t)KC_ELEMS + (size_t)layer * KL_ELEMS + (size_t)(b * 2 + kvh) * 1536 * 128 : (size_t)(b * 2 + kvh) * 256 * 128;
    const bf16_t* K = (const bf16_t*)(ws + WS_K) + koff; const bf16_t* Vc = (const bf16_t*)(ws + WS_V) + koff;
    const bf16_t* Vz = Z + (size_t)tok0 * NZ + ZV + kvh * 128;
    bf16_t* mix = (bf16_t*)(ws + WS_H) + (size_t)tok * 2048 + h * 128;
    const bf16_t* ag = Z + (size_t)tok * NZ + ZAG + h * 128;
    att::attn_dense_body(Q, K, Vc, Vz, LAT ? 512 : 0, p.in[I_QN] + layer * 128, (const float*)(ws + WS_ROPE), qb * 256, LAT, mix, ag, LAT ? 1536 : 256, (char*)lds_generic);
    __syncthreads();
}

DI void phaseC(const P& p, LAS unsigned char* lds, unsigned char* lds_generic, int layer, int ctr_idx, int types) {
    TID_SETUP
    unsigned* ctr = (unsigned*)(p.ws + WS_CTL) + ctr_idx;
    LAS unsigned* slot = (LAS unsigned*)(lds + LDS_MISC);
    for (;;) {
        if (tid == 0) *slot = atomicAdd(ctr, 1u);
        __syncthreads();
        const int id = __builtin_amdgcn_readfirstlane((int)*slot);
        __syncthreads();
        if (id >= 640) break;
        { const int ty = id < 128 ? 1 : id < 256 ? 4 : id < 384 ? 2 : id < 512 ? 8 : 16; if (!(types & ty)) continue; }
        if (id < 128 || id >= 512) { const bool la = id < 128; const int u = la ? id : id - 512; attn_task(p, lds_generic, layer, la, la ? u >> 5 : u >> 3, la ? (u >> 2) & 7 : u & 7, la ? u & 3 : 0); }
        else if (id >= 256 && id < 384) { m1_group(p, lds, layer, id - 256); }
        else if (id < 256) { const int u = id - 128; fourier_task<true>(p, lds, layer, u >> 5, (u >> 3) & 3, u & 7); }
        else if (id < 512) { const int u = id - 384; fourier_task<false>(p, lds, layer, u >> 3, (u >> 1) & 3, u & 1); }
    }
}

__global__ void __launch_bounds__(512, 2) mega_fwd(P p) {
    extern __shared__ __attribute__((aligned(16))) unsigned char lds_raw[];
    LAS unsigned char* lds = (LAS unsigned char*)lds_raw;
    cg::grid_group grid = cg::this_grid();
    if (threadIdx.x < 4) ((LAS unsigned*)(lds + LDS_MISC))[4 + threadIdx.x] = 0u;
    __syncthreads();
    XcdBarrier xbar = xcd_barrier_post((unsigned*)(p.ws + WS_BAR), (volatile LAS unsigned*)(lds + LDS_MISC) + 4);
    (void)xbar;
#define GSYNC() do { XcdBarrier xb_; xb_.bar = (unsigned*)(p.ws + WS_BAR); xb_.x = xb_xcc_id(); xb_.st = (volatile LAS unsigned*)(lds + LDS_MISC) + 4; xcd_barrier(xb_); } while (0)
    unsigned char* ws = p.ws;
#ifndef DUPMASK
#define DUPMASK 0
#endif
#ifndef DUPC_TYPES
#define DUPC_TYPES 31
#endif
    phase0(p, lds, 0);
    if (p.ws == nullptr) grid.sync();
    GSYNC();
    if (DUPMASK & 1) { phase0(p, lds, 512); GSYNC(); }
    if (DUPMASK & 128) { for (int q = 0; q < 10; ++q) GSYNC(); }
#pragma unroll 1
    for (int layer = 0; layer < 2; ++layer) {
#pragma unroll 1
        for (int rp = 0; rp < ((DUPMASK & 2) ? 2 : 1); ++rp) { phaseA(p, lds, layer); GSYNC(); }
#pragma unroll 1
        for (int rp = 0; rp < ((DUPMASK & 4) ? 2 : 1); ++rp) {
            pg8::Gemm g{(const pg8::bf16_t*)(ws + WS_H), (const pg8::bf16_t*)(ws + WS_WINT) + (size_t)layer * 6144 * 2048, NTOK, NZ, DM};
            pg8::StaticOrder S; S.init(NTOK, NZ, (int)gridDim.x, (int)blockIdx.x);
            pg8::EpiZ E{(pg8::bf16_t*)(ws + WS_Z), NZ, p.out + O_NV + (size_t)layer * 65536};
            pg8::gemm_phase<pg8::EpiZ, pg8::StaticOrder, true, true>(lds, g, S, E);
            GSYNC(); }
#pragma unroll 1
        for (int rp = 0; rp < ((DUPMASK & 8) ? 2 : 1); ++rp) { phaseB2(p, lds, layer); gate_scan_phase(p, lds, layer); GSYNC(); }
#pragma unroll 1
        for (int rp = 0; rp < ((DUPMASK & 16) ? 2 : 1); ++rp) { phaseC(p, lds, lds_raw, layer, 64 * (1 + layer + 2 * rp), rp ? DUPC_TYPES : 31); GSYNC(); }
#pragma unroll 1
        for (int rp = 0; rp < ((DUPMASK & 32) ? 2 : 1); ++rp) {
            for (int slot = blockIdx.x; slot < 256; slot += gridDim.x) m2_block(p, layer, slot);
            GSYNC();
            for (int s = blockIdx.x; s < 512; s += gridDim.x) m3_task(p, lds, layer, s);
            GSYNC(); }
#pragma unroll 1
        for (int rp = 0; rp < ((DUPMASK & 64) ? 2 : 1); ++rp) {
            pg8::Gemm g{(const pg8::bf16_t*)(ws + WS_H), (const pg8::bf16_t*)(ws + WS_WOUTT) + (size_t)layer * 2048 * 2048, NTOK, DM, DM};
            pg8::StaticOrder S; S.init(NTOK, DM, (int)gridDim.x, (int)blockIdx.x);
            const float* modl = (const float*)(ws + WS_MOD) + (size_t)layer * 5 * 6144;
            if (layer == 0) { pg8::EpiRes<false> E{p.in[I_XP], p.in[I_XS], nullptr, (pg8::bf16_t*)(ws + WS_X1B), nullptr, modl}; pg8::gemm_phase<pg8::EpiRes<false>, pg8::StaticOrder, true, true>(lds, g, S, E); }
            else { pg8::EpiRes<true> E{nullptr, nullptr, (const pg8::bf16_t*)(ws + WS_X1B), nullptr, p.out, modl}; pg8::gemm_phase<pg8::EpiRes<true>, pg8::StaticOrder, true, true>(lds, g, S, E); }
            if (layer == 0 || rp + 1 < ((DUPMASK & 64) ? 2 : 1)) GSYNC(); }
    }
}

extern "C" void kernel_launch(void* const* d_in, const int* in_sizes, int n_in, void* d_out, int out_size, void* d_ws, size_t ws_size, hipStream_t stream) {
    static int grid = 0;
    if (grid == 0) {
        if (n_in != 21 || (size_t)out_size != O_END || ws_size < WS_END) { fprintf(stderr, "kernel_launch: unexpected shapes: n_in %d out %d ws %zu (need %zu)\n", n_in, out_size, ws_size, (size_t)WS_END); grid = -1; return; }
        int dev = 0, cus = 0, per_cu = 0;
        hipGetDevice(&dev); hipDeviceGetAttribute(&cus, hipDeviceAttributeMultiprocessorCount, dev);
        if (hipFuncSetAttribute((const void*)mega_fwd, hipFuncAttributeMaxDynamicSharedMemorySize, LDS_BYTES) != hipSuccess) { fprintf(stderr, "kernel_launch: hipFuncSetAttribute failed\n"); grid = -1; return; }
        hipOccupancyMaxActiveBlocksPerMultiprocessor(&per_cu, (const void*)mega_fwd, 512, LDS_BYTES);
        if (per_cu < 1) { fprintf(stderr, "kernel_launch: occupancy query says %d blocks per CU\n", per_cu); per_cu = 1; }
        (void)hipGetLastError();
        grid = cus;
    }
    if (grid < 0) return;
    hipMemsetAsync((char*)d_ws + WS_CTL, 0, 32768, stream);
    P p{};
    for (int i = 0; i < 21; ++i) p.in[i] = (const float*)d_in[i];
    p.out = (float*)d_out; p.ws = (unsigned char*)d_ws;
    void* args[] = {&p};
    hipError_t e = hipLaunchCooperativeKernel((const void*)mega_fwd, dim3(grid), dim3(512), args, LDS_BYTES, stream);
    if (e != hipSuccess) fprintf(stderr, "kernel_launch: cooperative launch failed: %s (grid %d)\n", hipGetErrorString(e), grid);
}
```

```cpp
#include <hip/hip_runtime.h>
#include <hip/hip_cooperative_groups.h>
#include <cstdio>
#include <cstdint>
namespace cg = cooperative_groups;

namespace pg8 {
#define PG8_LAS __attribute__((address_space(3)))
typedef unsigned short bf16_t;
typedef short bf16x8 __attribute__((ext_vector_type(8)));
typedef float f32x4 __attribute__((ext_vector_type(4)));
typedef unsigned u32x4 __attribute__((ext_vector_type(4)));
constexpr int BM = 256, BK = 64, HALF = 128, HTB = HALF * BK * 2  , STAGE_BYTES = 8 * HTB, NXCD = 8, WGM = 8;

__host__ __device__ __forceinline__ int lds_byte(int r, int c) { const int st = (r >> 4) * 2 + (c >> 5), rr = r & 15, cc = c & 31, ob = rr * 64 + cc * 2; return st * 1024 + (ob ^ (((ob >> 9) & 1) << 5)); }
__host__ __device__ __forceinline__ void stage_rc(int b, int& R, int& C) { const int st = b / 1024, sb = b % 1024, swz = sb ^ (((sb >> 9) & 1) << 5); R = (st >> 1) * 16 + swz / 64; C = (st & 1) * 32 + (swz % 64) / 2; }
__host__ __device__ __forceinline__ int perm32(int rho) { const int n = rho >> 4, i = rho & 15; return 8 * (i >> 2) + 4 * n + (i & 3); }

struct Unit { int pm, pn; };
struct Gemm { const bf16_t* A; const bf16_t* Bt; int M, N, K; };

struct StaticOrder {
    int nM, nN, nwg, G, c;
    __host__ __device__ void init(int M, int N, int G_, int c_) { nM = M / BM; nN = N / BM; nwg = nM * nN; G = G_; c = c_; }
    __host__ __device__ bool next(int i, Unit& u) const {
        const long L = (long)i * G + c; if (L >= nwg) return false;
        int wgid = (int)L; { const int q = nwg / NXCD, r = nwg % NXCD, xcd = wgid % NXCD, off = wgid / NXCD; wgid = (xcd < r ? xcd * (q + 1) : r * (q + 1) + (xcd - r) * q) + off; }
        const int nig = WGM * nN, gid = wgid / nig, fm = gid * WGM, gsz = (nM - fm) < WGM ? (nM - fm) : WGM;
        u.pm = fm + ((wgid % nig) % gsz); u.pn = (wgid % nig) / gsz; return true;
    }
    __device__ __forceinline__ void a_ready(const Unit&) const {}
    __device__ __forceinline__ void done(const Unit&) const {}
};
__device__ __forceinline__ unsigned cvt_pk_bf16(float lo, float hi) { unsigned r; asm volatile("v_cvt_pk_bf16_f32 %0, %1, %2" : "=v"(r) : "v"(lo), "v"(hi)); return r; }

struct EpiZ {
    static constexpr bool PERM = true, AFTER_DRAIN = false;
    bf16_t* O; int ldc; float* nv;
    __device__ __forceinline__ void operator()(const f32x4 (&acc)[2][2][4][2], const Unit& u, int wr, int wc, int fr, int fq) const {
        const int row0 = u.pm * BM + wr * 64 + fr, col0 = u.pn * BM + wc * 32 + 8 * fq;
#pragma unroll
        for (int ai = 0; ai < 2; ++ai)
#pragma unroll
            for (int m = 0; m < 4; ++m) { bf16_t* rowp = O + (size_t)(row0 + ai * HALF + m * 16) * ldc + col0;
#pragma unroll
                for (int bj = 0; bj < 2; ++bj) { const f32x4 v0 = acc[ai][bj][m][0], v1 = acc[ai][bj][m][1];
                    u32x4 w; w.x = cvt_pk_bf16(v0[0], v0[1]); w.y = cvt_pk_bf16(v0[2], v0[3]); w.z = cvt_pk_bf16(v1[0], v1[1]); w.w = cvt_pk_bf16(v1[2], v1[3]);
                    *(u32x4*)(rowp + bj * HALF) = w;
                    if (u.pn == 5 && u.pm < 16) { const int row = row0 + ai * HALF + m * 16; float* o = nv + ((size_t)(row >> 8) * 512 + (row & 255)) * 256 + (col0 + bj * HALF - 1280); __builtin_nontemporal_store(v0, (f32x4*)o); __builtin_nontemporal_store(v1, (f32x4*)(o + 4)); } } }
    }
};
template <bool L1> struct EpiRes {
    static constexpr bool PERM = false, AFTER_DRAIN = false;
    const float* xa; const float* xb; const bf16_t* x1in; bf16_t* x1out; float* out; const float* mod;
    __device__ __forceinline__ void operator()(const f32x4 (&acc)[2][2][4][2], const Unit& u, int wr, int wc, int fr, int fq) const {
        const int row0 = u.pm * BM + wr * 64 + fr, col0 = u.pn * BM + wc * 32 + 4 * fq;
        const int ci = u.pm < 16 ? 0 : 1 + ((u.pm - 16) >> 2);
        const float* gate = mod + ci * 6144 + 4096;
        f32x4 gv[2][2];
#pragma unroll
        for (int bj = 0; bj < 2; ++bj)
#pragma unroll
            for (int n = 0; n < 2; ++n) gv[bj][n] = *(const f32x4*)(gate + col0 + bj * HALF + n * 16);
#pragma unroll
        for (int ai = 0; ai < 2; ++ai)
#pragma unroll
            for (int m = 0; m < 4; ++m) { const int r = row0 + ai * HALF + m * 16;
                const float* xin = (u.pm < 16) ? xa + (size_t)r * 2048 : xb + (size_t)(r - 4096) * 2048;
#pragma unroll
                for (int bj = 0; bj < 2; ++bj)
#pragma unroll
                    for (int n = 0; n < 2; ++n) { const int c = col0 + bj * HALF + n * 16;
                        if constexpr (L1) { const unsigned long long xw = __builtin_nontemporal_load((const unsigned long long*)(x1in + (size_t)r * 2048 + c));
                            f32x4 xv; xv[0] = __uint_as_float((unsigned)xw << 16); xv[1] = __uint_as_float((unsigned)xw & 0xffff0000u); xv[2] = __uint_as_float((unsigned)(xw >> 32) << 16); xv[3] = __uint_as_float((unsigned)(xw >> 32) & 0xffff0000u);
                            __builtin_nontemporal_store(xv + gv[bj][n] * acc[ai][bj][m][n], (f32x4*)(out + (size_t)r * 2048 + c)); }
                        else { const f32x4 xv = __builtin_nontemporal_load((const f32x4*)(xin + c)); const f32x4 y = xv + gv[bj][n] * acc[ai][bj][m][n];
                            const unsigned long long w = (unsigned long long)cvt_pk_bf16(y[0], y[1]) | ((unsigned long long)cvt_pk_bf16(y[2], y[3]) << 32);
                            *(unsigned long long*)(x1out + (size_t)r * 2048 + c) = w; } } }
    }
};
template <class Epi, class Sched, bool ALIGN_EPI = false, bool SP2 = false>
__device__ __forceinline__ void gemm_phase(PG8_LAS unsigned char* lds, const Gemm g, const Sched& S, const Epi& E) {
    int tid_ = threadIdx.x; asm volatile("" : "+v"(tid_));
    const int tid = tid_, wid = __builtin_amdgcn_readfirstlane(tid >> 6), lane = tid & 63, wr = wid >> 2, wc = wid & 3, fr = lane & 15, fq = lane >> 4;
    const int K = g.K, nt = K / BK;
    unsigned voffA[2], voffB[2];
#pragma unroll
    for (int i = 0; i < 2; ++i) { int R, C; stage_rc(tid * 16 + i * 8192, R, C); const int Rb = Epi::PERM ? ((R & ~31) + perm32(R & 31)) : R;
        voffA[i] = (unsigned)(R * K + C) * 2u; voffB[i] = (unsigned)(Rb * K + C) * 2u; }
    const size_t kstep = (size_t)(BK * 2);
    const size_t hstep = (size_t)HALF * K * 2;
    const size_t tstep = 2 * hstep;
    const unsigned ldsw = (unsigned)wid * 1024u;
    const int aoff = lds_byte(wr * 64 + fr, fq * 8), boff = lds_byte(wc * 32 + fr, fq * 8);
#define PG8_SA(b, h) (((b) * 2 + (h)) * HTB)
#define PG8_SB(b, h) ((4 + (b) * 2 + (h)) * HTB)
#define PG8_STAGE(bufoff, gbase, voff) do { _Pragma("unroll") for (int _i = 0; _i < 2; ++_i) \
        __builtin_amdgcn_global_load_lds((const unsigned*)((const char*)(gbase) + (voff)[_i]), (PG8_LAS unsigned*)(lds + (bufoff) + ldsw + _i * 8192), 16, 0, 0); } while (0)
#define PG8_LDA(dst, b, h) do { _Pragma("unroll") for (int m = 0; m < 4; ++m) _Pragma("unroll") for (int k = 0; k < 2; ++k) dst[m][k] = *(const PG8_LAS bf16x8*)(lds + PG8_SA(b, h) + aoff + m * 2048 + k * 1024); } while (0)
#define PG8_LDB(dst, b, h) do { _Pragma("unroll") for (int n = 0; n < 2; ++n) _Pragma("unroll") for (int k = 0; k < 2; ++k) dst[n][k] = *(const PG8_LAS bf16x8*)(lds + PG8_SB(b, h) + boff + n * 2048 + k * 1024); } while (0)
#define PG8_MMA(ai, bj, At, Bt) do { __builtin_amdgcn_s_setprio(1); _Pragma("unroll") for (int m = 0; m < 4; ++m) _Pragma("unroll") for (int n = 0; n < 2; ++n) _Pragma("unroll") for (int k = 0; k < 2; ++k) \
        acc[ai][bj][m][n] = __builtin_amdgcn_mfma_f32_16x16x32_bf16(Bt[n][k], At[m][k], acc[ai][bj][m][n], 0, 0, 0); __builtin_amdgcn_s_setprio(0); } while (0)
#define PG8_WAIT_V(n) asm volatile("s_waitcnt vmcnt(" #n ")" ::: "memory")
#define PG8_WAIT_L(n) asm volatile("s_waitcnt lgkmcnt(" #n ")" ::: "memory")
#define PG8_BAR __builtin_amdgcn_s_barrier()
#define PG8_SCHED __builtin_amdgcn_sched_barrier(0)
    Unit cur, nxt; int ui = 0;
    if (!S.next(0, cur)) return;
    f32x4 acc[2][2][4][2];
#pragma unroll
    for (int a = 0; a < 2; ++a)
#pragma unroll
        for (int b = 0; b < 2; ++b)
#pragma unroll
            for (int m = 0; m < 4; ++m)
#pragma unroll
                for (int n = 0; n < 2; ++n) acc[a][b][m][n] = (f32x4){0.f, 0.f, 0.f, 0.f};
    bf16x8 At[4][2], B0[2][2], B1[2][2];
    const char* cA = (const char*)g.A + (size_t)cur.pm * tstep; const char* cB = (const char*)g.Bt + (size_t)cur.pn * tstep;
    S.a_ready(cur);
    if constexpr (SP2) {
        PG8_STAGE(PG8_SB(0, 0), cB, voffB); PG8_STAGE(PG8_SB(0, 1), cB + hstep, voffB); PG8_STAGE(PG8_SA(0, 0), cA, voffA); PG8_STAGE(PG8_SA(0, 1), cA + hstep, voffA);
        if (wr == 1) PG8_BAR;
        PG8_WAIT_V(2); PG8_BAR;
        PG8_STAGE(PG8_SB(1, 0), cB + kstep, voffB); PG8_STAGE(PG8_SA(1, 0), cA + kstep, voffA); PG8_STAGE(PG8_SB(1, 1), cB + hstep + kstep, voffB);
        PG8_WAIT_V(6); PG8_BAR;
    } else {
        PG8_STAGE(PG8_SB(0, 0), cB, voffB); PG8_STAGE(PG8_SA(0, 0), cA, voffA); PG8_STAGE(PG8_SB(0, 1), cB + hstep, voffB); PG8_STAGE(PG8_SA(0, 1), cA + hstep, voffA);
        if (wr == 1) PG8_BAR;
        PG8_WAIT_V(4); PG8_BAR;
        PG8_STAGE(PG8_SB(1, 0), cB + kstep, voffB); PG8_STAGE(PG8_SA(1, 0), cA + kstep, voffA); PG8_STAGE(PG8_SB(1, 1), cB + hstep + kstep, voffB);
        PG8_WAIT_V(6); PG8_BAR;
    }
    for (;;) {
        const bool has_next = S.next(ui + 1, nxt);
        const char* nA = has_next ? (const char*)g.A + (size_t)nxt.pm * tstep : cA; const char* nB = has_next ? (const char*)g.Bt + (size_t)nxt.pn * tstep : cB;
        for (int t = 0; t < nt; t += 2) {
            const bool last = (t == nt - 2);
            const char* a1 = cA + (size_t)(t + 1) * kstep;
            const char* a2 = last ? nA : cA + (size_t)(t + 2) * kstep; const char* b2 = last ? nB : cB + (size_t)(t + 2) * kstep;
            const char* a3 = a2 + kstep; const char* b3 = b2 + kstep;
            if (last && has_next) S.a_ready(nxt);
            if constexpr (SP2) {
            PG8_LDB(B0, 0, 0); PG8_LDB(B1, 0, 1); PG8_SCHED; PG8_LDA(At, 0, 0); PG8_STAGE(PG8_SA(1, 1), a1 + hstep, voffA);
            PG8_WAIT_V(8); PG8_WAIT_L(0); PG8_BAR; PG8_MMA(0, 0, At, B0); PG8_MMA(0, 1, At, B1); PG8_BAR; PG8_SCHED;
            PG8_LDA(At, 0, 1); PG8_STAGE(PG8_SB(0, 0), b2, voffB); PG8_STAGE(PG8_SB(0, 1), b2 + hstep, voffB); PG8_STAGE(PG8_SA(0, 0), a2, voffA);
            PG8_WAIT_V(8); PG8_WAIT_L(0); PG8_BAR; PG8_MMA(1, 0, At, B0); PG8_MMA(1, 1, At, B1); PG8_BAR; PG8_SCHED;
            PG8_LDB(B0, 1, 0); PG8_LDB(B1, 1, 1); PG8_SCHED; PG8_LDA(At, 1, 0); PG8_STAGE(PG8_SA(0, 1), a2 + hstep, voffA);
            PG8_WAIT_V(8); PG8_WAIT_L(0); PG8_BAR; PG8_MMA(0, 0, At, B0); PG8_MMA(0, 1, At, B1); PG8_BAR; PG8_SCHED;
            PG8_LDA(At, 1, 1); PG8_STAGE(PG8_SB(1, 0), b3, voffB); PG8_STAGE(PG8_SB(1, 1), b3 + hstep, voffB); PG8_STAGE(PG8_SA(1, 0), a3, voffA);
            PG8_WAIT_V(8); PG8_WAIT_L(0); PG8_BAR; PG8_MMA(1, 0, At, B0); PG8_MMA(1, 1, At, B1); PG8_BAR; PG8_SCHED;
            } else {
            PG8_LDB(B0, 0, 0); PG8_SCHED; PG8_LDA(At, 0, 0); PG8_STAGE(PG8_SA(1, 1), a1 + hstep, voffA);
            PG8_WAIT_L(8); PG8_BAR; PG8_WAIT_L(0); PG8_MMA(0, 0, At, B0); PG8_BAR; PG8_SCHED;
            PG8_LDB(B1, 0, 1); PG8_STAGE(PG8_SB(0, 0), b2, voffB);
            PG8_BAR; PG8_WAIT_L(0); PG8_MMA(0, 1, At, B1); PG8_BAR;
            PG8_LDA(At, 0, 1); PG8_STAGE(PG8_SA(0, 0), a2, voffA);
            PG8_BAR; PG8_WAIT_L(0); PG8_MMA(1, 0, At, B0); PG8_BAR; PG8_SCHED;
            PG8_STAGE(PG8_SB(0, 1), b2 + hstep, voffB);
            PG8_WAIT_V(6); PG8_BAR; PG8_MMA(1, 1, At, B1); PG8_BAR;
            PG8_LDB(B0, 1, 0); PG8_SCHED; PG8_LDA(At, 1, 0); PG8_STAGE(PG8_SA(0, 1), a2 + hstep, voffA);
            PG8_WAIT_L(8); PG8_BAR; PG8_WAIT_L(0); PG8_MMA(0, 0, At, B0); PG8_BAR; PG8_SCHED;
            PG8_LDB(B1, 1, 1); PG8_STAGE(PG8_SB(1, 0), b3, voffB);
            PG8_BAR; PG8_WAIT_L(0); PG8_MMA(0, 1, At, B1); PG8_BAR;
            PG8_LDA(At, 1, 1); PG8_STAGE(PG8_SA(1, 0), a3, voffA);
            PG8_BAR; PG8_WAIT_L(0); PG8_MMA(1, 0, At, B0); PG8_BAR; PG8_SCHED;
            PG8_STAGE(PG8_SB(1, 1), b3 + hstep, voffB);
            PG8_WAIT_V(6); PG8_BAR; PG8_MMA(1, 1, At, B1); PG8_BAR;
            }
        }
        if constexpr (ALIGN_EPI) { if (wr == 0) PG8_BAR; }
        if constexpr (!Epi::AFTER_DRAIN) { E(acc, cur, wr, wc, fr, fq); S.done(cur); }
        if (!has_next) break;
#pragma unroll
        for (int a = 0; a < 2; ++a)
#pragma unroll
            for (int b = 0; b < 2; ++b)
#pragma unroll
                for (int m = 0; m < 4; ++m)
#pragma unroll
                    for (int n = 0; n < 2; ++n) acc[a][b][m][n] = (f32x4){0.f, 0.f, 0.f, 0.f};
        cur = nxt; cA = nA; cB = nB; ++ui;
        if constexpr (ALIGN_EPI) { if (wr == 1) PG8_BAR; }
    }
    PG8_WAIT_V(0);
    if constexpr (!ALIGN_EPI) { if (wr == 0) PG8_BAR; }
    PG8_BAR;
    if constexpr (Epi::AFTER_DRAIN) { E.fused(acc, cur, wr, wc, fr, fq, lds, wid, lane); S.done(cur); }
#undef PG8_SA
#undef PG8_SB
#undef PG8_STAGE
#undef PG8_LDA
#undef PG8_LDB
#undef PG8_MMA
#undef PG8_WAIT_V
#undef PG8_WAIT_L
#undef PG8_BAR
#undef PG8_SCHED
}

}

namespace att {
using bf16 = unsigned short;
constexpr int   D = 128, NW = 8, QBLK = 32, KVBLK = 64;
constexpr float SCALE = 0.088388347648318440f;
constexpr float THR = 8.f;
constexpr int SDEPTH = 1;
constexpr int LDQ = 128, LDK = 128;
constexpr size_t SHM_V = KVBLK * D * 2, SHM_K = KVBLK * D * 2, SHM_ATTN = 2 * SHM_V + 2 * SHM_K + NW * 64 * 4;
using bf16x8 = __attribute__((ext_vector_type(8))) short;
using s16x4  = __attribute__((ext_vector_type(4))) short;
using f32x16 = __attribute__((ext_vector_type(16))) float;
using f32x8  = __attribute__((ext_vector_type(8))) float;
using u32x4  = __attribute__((ext_vector_type(4))) unsigned;
#define KSWZ(row, colB) ((row) * 256 + ((colB) ^ (((row) & 7) << 4)))
#define SBAR() __builtin_amdgcn_sched_barrier(0)
__device__ __forceinline__ int crow(int r, int hi) { return (r & 3) + 8 * (r >> 2) + 4 * hi; }
__device__ __forceinline__ unsigned cvtpk(float lo, float hi) {
  unsigned r; asm volatile("v_cvt_pk_bf16_f32 %0, %1, %2" : "=v"(r) : "v"(lo), "v"(hi)); return r;
}
template <typename TIn> struct Stage;
template <> struct Stage<bf16>  { using T = bf16x8;
  __device__ static __forceinline__ T ld8(const bf16* p) { return *reinterpret_cast<const bf16x8*>(p); }
  __device__ static __forceinline__ bf16x8 tobf(T x) { return x; } };
template <> struct Stage<float> { using T = f32x8;
  __device__ static __forceinline__ T ld8(const float* p) { return *reinterpret_cast<const f32x8*>(p); }
  __device__ static __forceinline__ bf16x8 tobf(T x) {
    u32x4 w = {cvtpk(x[0], x[1]), cvtpk(x[2], x[3]), cvtpk(x[4], x[5]), cvtpk(x[6], x[7])}; return *reinterpret_cast<bf16x8*>(&w); } };

__device__ __forceinline__ void partialSM(f32x16& p0, f32x16& p1, float& m_reg, float& mn, float& alpha) {
  constexpr float C = SCALE * 1.4426950408889634f;
  float pmax = p0[0]; for (int r = 1; r < 16; ++r) pmax = fmaxf(pmax, p0[r]); for (int r = 0; r < 16; ++r) pmax = fmaxf(pmax, p1[r]);
  { auto rr = __builtin_amdgcn_permlane32_swap(__float_as_uint(pmax), __float_as_uint(pmax), false, false);
    pmax = fmaxf(__uint_as_float(rr[0]), __uint_as_float(rr[1])); }
  if (__builtin_expect(__all(pmax - m_reg <= THR / SCALE), 1)) { mn = m_reg; alpha = 1.f; }
  else { mn = fmaxf(m_reg, pmax); alpha = __builtin_amdgcn_exp2f((m_reg - mn) * C); m_reg = mn; }
  float mnC = -mn * C;
  for (int r = 0; r < 16; ++r) p0[r] = fmaf(p0[r], C, mnC); for (int r = 0; r < 16; ++r) p1[r] = fmaf(p1[r], C, mnC);
  for (int r = 0; r < 16; ++r) p0[r] = __builtin_amdgcn_exp2f(p0[r]);
}
__device__ __forceinline__ void finishSM(f32x16& p0, f32x16& p1, float alpha, float& l_reg, bf16x8& pa0, bf16x8& pa1, bf16x8& pa2, bf16x8& pa3) {
  for (int r = 0; r < 16; ++r) p1[r] = __builtin_amdgcn_exp2f(p1[r]);
  float ps = 0; for (int r = 0; r < 16; ++r) ps += p0[r]; for (int r = 0; r < 16; ++r) ps += p1[r];
  { auto rr = __builtin_amdgcn_permlane32_swap(__float_as_uint(ps), __float_as_uint(ps), false, false);
    ps = __uint_as_float(rr[0]) + __uint_as_float(rr[1]); }
  l_reg = l_reg * alpha + ps;
#define PK4(P, BASE, OUT) do { unsigned a0 = cvtpk(P[BASE + 0], P[BASE + 1]), a1 = cvtpk(P[BASE + 2], P[BASE + 3]);   \
    unsigned b0 = cvtpk(P[BASE + 4], P[BASE + 5]), b1 = cvtpk(P[BASE + 6], P[BASE + 7]);                              \
    auto r0 = __builtin_amdgcn_permlane32_swap(a0, b0, false, false); auto r1 = __builtin_amdgcn_permlane32_swap(a1, b1, false, false); \
    u32x4 w = {r0[0], r1[0], r0[1], r1[1]}; OUT = *reinterpret_cast<bf16x8*>(&w); } while (0)
  PK4(p0, 0, pa0); PK4(p0, 8, pa1); PK4(p1, 0, pa2); PK4(p1, 8, pa3);
#undef PK4
}
__device__ __forceinline__ void qkt(f32x16& p0, f32x16& p1, const bf16* Ks, const bf16x8* qr, int r32, int hi) {
  p0 = f32x16{}; p1 = f32x16{};
  for (int d0 = 0; d0 < 8; ++d0) { int cb = (d0 * 16 + hi * 8) * 2;
    bf16x8 b0 = *reinterpret_cast<const bf16x8*>((const char*)Ks + KSWZ(r32, cb));
    bf16x8 b1 = *reinterpret_cast<const bf16x8*>((const char*)Ks + KSWZ(32 + r32, cb));
    p0 = __builtin_amdgcn_mfma_f32_32x32x16_bf16(b0, qr[d0], p0, 0, 0, 0);
    p1 = __builtin_amdgcn_mfma_f32_32x32x16_bf16(b1, qr[d0], p1, 0, 0, 0); }
}
__device__ __forceinline__ int v_st(int k, int c) { const int kk = (k & ~0xC) | ((k & 4) << 1) | ((k & 8) >> 1); return ((kk >> 3) * 4 + (c >> 5)) * 512 + ((kk & 7) * 32 + (c & 31)) * 2; }
__device__ __forceinline__ int v_rd_base(int lane) { return ((lane & 3) << 3) | (((lane >> 2) & 3) << 6) | (((lane >> 4) & 1) << 5) | (((lane >> 5) & 1) << 8); }
constexpr int v_rd_off(int d0, int ks, int half) { return d0 * 512 + ks * 4096 + half * 2048; }
template <int OFF> __device__ __forceinline__ s16x4 tr_read(int vb) {
  s16x4 r; asm volatile("ds_read_b64_tr_b16 %0, %1 offset:%2" : "=&v"(r) : "v"(vb), "i"(OFF) : "memory"); return r;
}
template <int D0> __device__ __forceinline__ void pv_one(f32x16& od, int vb, bf16x8 pa0, bf16x8 pa1, bf16x8 pa2, bf16x8 pa3) {
  const s16x4 l0 = tr_read<v_rd_off(D0, 0, 0)>(vb), h0 = tr_read<v_rd_off(D0, 0, 1)>(vb), l1 = tr_read<v_rd_off(D0, 1, 0)>(vb), h1 = tr_read<v_rd_off(D0, 1, 1)>(vb);
  const s16x4 l2 = tr_read<v_rd_off(D0, 2, 0)>(vb), h2 = tr_read<v_rd_off(D0, 2, 1)>(vb), l3 = tr_read<v_rd_off(D0, 3, 0)>(vb), h3 = tr_read<v_rd_off(D0, 3, 1)>(vb);
  asm volatile("s_waitcnt lgkmcnt(0)" ::: "memory"); SBAR();
#define PK(L, H) (bf16x8){L[0], L[1], L[2], L[3], H[0], H[1], H[2], H[3]}
  od = __builtin_amdgcn_mfma_f32_32x32x16_bf16(pa0, PK(l0, h0), od, 0, 0, 0);
  od = __builtin_amdgcn_mfma_f32_32x32x16_bf16(pa1, PK(l1, h1), od, 0, 0, 0);
  od = __builtin_amdgcn_mfma_f32_32x32x16_bf16(pa2, PK(l2, h2), od, 0, 0, 0);
  od = __builtin_amdgcn_mfma_f32_32x32x16_bf16(pa3, PK(l3, h3), od, 0, 0, 0);
#undef PK
}
__device__ __forceinline__ void pv_d0(f32x16* o, int vb, bf16x8 pa0, bf16x8 pa1, bf16x8 pa2, bf16x8 pa3) {
  pv_one<0>(o[0], vb, pa0, pa1, pa2, pa3); pv_one<1>(o[1], vb, pa0, pa1, pa2, pa3); pv_one<2>(o[2], vb, pa0, pa1, pa2, pa3); pv_one<3>(o[3], vb, pa0, pa1, pa2, pa3);
}


__device__ __forceinline__ void attn_dense_body(const bf16* __restrict__ Qb, const bf16* __restrict__ Kh, const bf16* __restrict__ Vc, const bf16* __restrict__ Vz, int vsplit,
                                                const float* __restrict__ qnw, const float* __restrict__ rope, int tq0, bool do_rope,
                                                bf16* __restrict__ Mix, const bf16* __restrict__ Ag, int seq, char* lds) {
  using TQ = bf16;
  using St = Stage<bf16>; using SQ = Stage<TQ>;
  int tid_ = threadIdx.x; asm volatile("" : "+v"(tid_));
  const int tid = tid_, wid = tid >> 6, lane = tid & 63, r32 = lane & 31, hi = lane >> 5;
  bf16* V_lds = (bf16*)lds; bf16* K_lds = (bf16*)(lds + 2 * SHM_V);
  float* ws = (float*)(lds + 2 * SHM_V + 2 * SHM_K) + wid * 64; float* li_l = ws; float* al_l = ws + 32;
  float m_reg = -1e30f, l_reg = 0; f32x16 o[4] = {}; bf16x8 qr[8];
  const TQ* Qw = Qb + (long)(wid * QBLK + r32) * 6144 + hi * 8;
#pragma unroll
  for (int d0 = 0; d0 < 8; ++d0) qr[d0] = SQ::tobf(SQ::ld8(Qw + d0 * 16));
  {
    float xq[8][8]; float ss = 0.f;
#pragma unroll
    for (int d0 = 0; d0 < 8; ++d0)
#pragma unroll
      for (int j = 0; j < 8; ++j) { xq[d0][j] = __uint_as_float(((unsigned)(unsigned short)qr[d0][j]) << 16); ss += xq[d0][j] * xq[d0][j]; }
    ss += __shfl_xor(ss, 32);
    const float rstd = rsqrtf(ss * (1.f / 128.f) + 1e-6f);
#pragma unroll
    for (int d0 = 0; d0 < 8; ++d0) { const float* wp = qnw + d0 * 16 + hi * 8;
#pragma unroll
      for (int j = 0; j < 8; ++j) xq[d0][j] *= rstd * wp[j]; }
    if (do_rope) { const int t = tq0 + wid * QBLK + r32, prow = t >> 6, pcol = t & 63;
#pragma unroll
      for (int g = 0; g < 2; ++g)
#pragma unroll
        for (int e = 0; e < 2; ++e) { const int d0 = 4 * g + e; const float* cs = rope + ((g ? pcol : prow) * 32 + 16 * e + 8 * hi) * 2;
#pragma unroll
          for (int j = 0; j < 8; ++j) { const float c = cs[2 * j], sn = cs[2 * j + 1], y1 = xq[d0][j], y2 = xq[d0 + 2][j];
            xq[d0][j] = y1 * c - y2 * sn; xq[d0 + 2][j] = y1 * sn + y2 * c; } } }
#pragma unroll
    for (int d0 = 0; d0 < 8; ++d0) { u32x4 w = {cvtpk(xq[d0][0], xq[d0][1]), cvtpk(xq[d0][2], xq[d0][3]), cvtpk(xq[d0][4], xq[d0][5]), cvtpk(xq[d0][6], xq[d0][7])}; qr[d0] = *reinterpret_cast<bf16x8*>(&w); }
  }
  const int voffc = (tid >> 4) * 128 + (tid & 15) * 8;
  const int sr = tid >> 4, sc = (tid & 15) * 8, vst0 = v_st(sr, sc), vst1 = v_st(32 + sr, sc);
  const int vb0 = (int)(uintptr_t)V_lds + v_rd_base(lane);
  struct { typename St::T vs0, vs1, ks0, ks1; } sr_[SDEPTH];
#define SLOAD(i, k0) do { const bool vc_ = (k0) < vsplit; const bf16* vb_ = vc_ ? Vc + (long)(k0) * 128 : Vz + (long)((k0) - vsplit) * 6144; const int vo_ = vc_ ? voffc : voffc + (tid >> 4) * 6016, v32_ = vc_ ? 32 * 128 : 32 * 6144; \
    sr_[i].vs0 = St::ld8(&vb_[vo_]); sr_[i].vs1 = St::ld8(&vb_[vo_ + v32_]); \
    sr_[i].ks0 = St::ld8(&Kh[(long)((k0) + sr) * LDK + sc]); sr_[i].ks1 = St::ld8(&Kh[(long)((k0) + 32 + sr) * LDK + sc]); } while (0)
#define SWRITE(b, i) do { *(bf16x8*)((char*)V_lds + (b) * SHM_V + vst0) = St::tobf(sr_[i].vs0);          \
    *(bf16x8*)((char*)V_lds + (b) * SHM_V + vst1) = St::tobf(sr_[i].vs1); int kc = sc * 2;               \
    *(bf16x8*)((char*)K_lds + (b) * SHM_K + KSWZ(sr, kc)) = St::tobf(sr_[i].ks0);                       \
    *(bf16x8*)((char*)K_lds + (b) * SHM_K + KSWZ(32 + sr, kc)) = St::tobf(sr_[i].ks1); } while (0)
#define SWAIT() do { if constexpr (SDEPTH == 2) asm volatile("s_waitcnt vmcnt(4)" ::: "memory"); else asm volatile("s_waitcnt vmcnt(0)" ::: "memory"); } while (0)
#define RESC(a) do { if (__any((a) < 1.f)) { if (hi == 0) al_l[r32] = (a); asm volatile("s_waitcnt lgkmcnt(0)" ::: "memory"); \
    for (int d = 0; d < 4; ++d) for (int r = 0; r < 16; ++r) o[d][r] *= al_l[crow(r, hi)]; } } while (0)
  f32x16 pA0, pA1, pB0, pB1; float mnA, mnB, alA, alB; bf16x8 pa0, pa1, pa2, pa3; const int NT = seq / KVBLK;
  constexpr int SE = 0, SO = SDEPTH - 1;
  SLOAD(SE, 0); asm volatile("s_waitcnt vmcnt(0)" ::: "memory"); SWRITE(0, SE); __syncthreads();
  qkt(pA0, pA1, K_lds, qr, r32, hi); partialSM(pA0, pA1, m_reg, mnA, alA);
  SLOAD(SO, KVBLK); if constexpr (SDEPTH == 2) { if (2 < NT) SLOAD(SE, 2 * KVBLK); }
  SWAIT(); SWRITE(1, SO); __syncthreads();
  for (int j = 1; j + 1 < NT; j += 2) {
    SBAR(); qkt(pB0, pB1, (bf16*)((char*)K_lds + SHM_K), qr, r32, hi);
    finishSM(pA0, pA1, alA, l_reg, pa0, pa1, pa2, pa3); SBAR();
    SLOAD(SO, (j + SDEPTH) * KVBLK); SBAR();
    pv_d0(o, vb0, pa0, pa1, pa2, pa3); partialSM(pB0, pB1, m_reg, mnB, alB);
    __syncthreads(); SWAIT(); SWRITE(0, SE);
    RESC(alB); __syncthreads();
    SBAR(); qkt(pA0, pA1, K_lds, qr, r32, hi);
    finishSM(pB0, pB1, alB, l_reg, pa0, pa1, pa2, pa3); SBAR();
    if (SDEPTH == 1 || j + 3 < NT) SLOAD(SE, (j + 1 + SDEPTH) * KVBLK); SBAR();
    pv_d0(o, vb0 + (int)SHM_V, pa0, pa1, pa2, pa3); partialSM(pA0, pA1, m_reg, mnA, alA);
    __syncthreads(); SWAIT(); SWRITE(1, SO);
    RESC(alA); __syncthreads();
  }
  SBAR(); qkt(pB0, pB1, (bf16*)((char*)K_lds + SHM_K), qr, r32, hi);
  finishSM(pA0, pA1, alA, l_reg, pa0, pa1, pa2, pa3); SBAR();
  pv_d0(o, vb0, pa0, pa1, pa2, pa3); partialSM(pB0, pB1, m_reg, mnB, alB);
  __syncthreads(); RESC(alB);
  finishSM(pB0, pB1, alB, l_reg, pa0, pa1, pa2, pa3); SBAR();
  pv_d0(o, vb0 + (int)SHM_V, pa0, pa1, pa2, pa3);
  if (hi == 0) li_l[r32] = l_reg; asm volatile("s_waitcnt lgkmcnt(0)" ::: "memory");
  float rli[16];
#pragma unroll
  for (int r = 0; r < 16; ++r) rli[r] = __builtin_amdgcn_rcpf(li_l[crow(r, hi)]);
  bf16* Mw = Mix + (long)(wid * QBLK) * 2048; const bf16* Aw = Ag + (long)(wid * QBLK) * 6144;
#pragma unroll
  for (int r = 0; r < 16; ++r) { int orow = crow(r, hi);
#pragma unroll
    for (int d0 = 0; d0 < 4; ++d0) { const float g = __uint_as_float(((unsigned)Aw[(long)orow * 6144 + d0 * 32 + r32]) << 16);
      const float val = o[d0][r] * rli[r] * (g * __builtin_amdgcn_rcpf(1.f + __expf(-g)));
      Mw[(long)orow * 2048 + d0 * 32 + r32] = (bf16)cvtpk(val, val); } }
#undef SLOAD
#undef SWRITE
#undef SWAIT
#undef RESC
}

}

#define DI __device__ __forceinline__
#define LAS __attribute__((address_space(3)))
typedef unsigned short bf16_t;
typedef short bf16x8 __attribute__((ext_vector_type(8)));
typedef float f32x4 __attribute__((ext_vector_type(4)));
typedef float f32x16 __attribute__((ext_vector_type(16)));
typedef unsigned u32x4 __attribute__((ext_vector_type(4)));
typedef unsigned u32x2 __attribute__((ext_vector_type(2)));
#define TID_SETUP int tid = threadIdx.x; asm volatile("" : "+v"(tid)); const int lane = tid & 63, wave = __builtin_amdgcn_readfirstlane(tid >> 6); (void)lane; (void)wave;
#define MFMA32(a, b, c) __builtin_amdgcn_mfma_f32_32x32x16_bf16((a), (b), (c), 0, 0, 0)

#define XB_TMO      128
#define XB_XCNT(j)  (256  + 64 * (j))
#define XB_XSUB(j)  (1280 + 64 * (j))
#define XB_XGEN(j)  (2304 + 64 * (j))
#define XB_TOP      3328
#define XB_TOPGEN   3392
#define XCD_BAR_WORDS 3456
#define XB_SPIN_CAP (1u << 18)
__device__ __forceinline__ unsigned xb_ld(unsigned* p)              { return __hip_atomic_load(p, __ATOMIC_RELAXED, __HIP_MEMORY_SCOPE_AGENT); }
__device__ __forceinline__ unsigned xb_add(unsigned* p, unsigned v) { return __hip_atomic_fetch_add(p, v, __ATOMIC_RELAXED, __HIP_MEMORY_SCOPE_AGENT); }
__device__ __forceinline__ unsigned xb_xcc_id() { return (unsigned)__builtin_amdgcn_s_getreg((3 << 11) | 20) & 0xFu; }
#define XB_SPIN(cond, bar) do { unsigned _sp = 0; while (cond) { __builtin_amdgcn_s_sleep(1); \
    if ((++_sp & 255u) == 0u) { if (xb_ld(&(bar)[XB_TMO])) break; if (_sp > XB_SPIN_CAP) { atomicAdd(&(bar)[XB_TMO], 1u); break; } } } } while (0)

struct XcdBarrier {
    unsigned* bar; unsigned x;
    volatile LAS unsigned* st;
};

__device__ __forceinline__ XcdBarrier xcd_barrier_post(unsigned* bar, volatile LAS unsigned* st) {
    XcdBarrier b; b.bar = bar; b.x = xb_xcc_id(); b.st = st;
    if (threadIdx.x == 0) (void)xb_add(&bar[XB_XCNT(b.x)], 1u);
    return b;
}
__device__ __forceinline__ void xcd_barrier_complete(unsigned* bar, unsigned x, unsigned& nloc, unsigned& nx) {
    const unsigned G = gridDim.x * gridDim.y * gridDim.z;
    unsigned sum, cnt, mine, sp = 0u;
    for (;;) {
        sum = 0u; cnt = 0u; mine = 0u;
#pragma unroll
        for (unsigned j = 0; j < 16; ++j) { const unsigned c = xb_ld(&bar[XB_XCNT(j)]); sum += c; cnt += (c > 0u) ? 1u : 0u; mine = (j == x) ? c : mine; }
        if (sum == G) break;
        __builtin_amdgcn_s_sleep(1);
        if ((++sp & 255u) == 0u) { if (xb_ld(&bar[XB_TMO])) break; if (sp > XB_SPIN_CAP) { atomicAdd(&bar[XB_TMO], 1u); break; } }
    }
    nloc = mine > 0u ? mine : 1u; nx = cnt > 0u ? cnt : 1u;
}

__device__ __forceinline__ void xcd_barrier(const XcdBarrier& b) {
    asm volatile("s_waitcnt vmcnt(0)" ::: "memory");
    __syncthreads();
    if (threadIdx.x == 0) {
        unsigned* bar = b.bar;
        __builtin_amdgcn_s_waitcnt(0);
        unsigned nloc = b.st[0], nx = b.st[1];
        if (nloc == 0u) { xcd_barrier_complete(bar, b.x, nloc, nx); b.st[0] = nloc; b.st[1] = nx; }
        const unsigned old = xb_add(&bar[XB_XSUB(b.x)], 1u);
        const unsigned gen = old / nloc;
        if (old + 1u == (gen + 1u) * nloc) {
            __builtin_amdgcn_fence(__ATOMIC_RELEASE, "agent");
            asm volatile("s_waitcnt vmcnt(0)" ::: "memory");
            const unsigned og = xb_add(&bar[XB_TOP], 1u);
            const unsigned tg = og / nx;
            if (og + 1u == (tg + 1u) * nx) xb_add(&bar[XB_TOPGEN], 1u);
            else XB_SPIN(xb_ld(&bar[XB_TOPGEN]) == tg, bar);
            __builtin_amdgcn_fence(__ATOMIC_ACQUIRE, "agent");
            xb_add(&bar[XB_XGEN(b.x)], 1u);
            asm volatile("s_waitcnt vmcnt(0)" ::: "memory");
        } else {
            XB_SPIN(xb_ld(&bar[XB_XGEN(b.x)]) == gen, bar);
            __builtin_amdgcn_fence(__ATOMIC_ACQUIRE, "agent");
            asm volatile("s_waitcnt vmcnt(0)" ::: "memory");
        }
    }
    __syncthreads();
}

constexpr int NTOK = 8192, DM = 2048, NZ = 6144;
constexpr int ZQ = 0, ZK = 1024, ZV = 1280, ZAG = 1536, ZMQ = 2560, ZMK = 3072, ZMV = 3584, ZMO = 4096, ZMG = 4608, ZFX = 5120, ZFG = 5632;
constexpr float EPS = 1e-6f;
constexpr size_t O_YP = 0, O_YS = 8388608, O_NK = 16777216, O_NV = 18874368, O_NC = 20971520, O_NN = 25165824, O_NM = 25198592, O_END = 25198848;
constexpr size_t WS_CTL = 0;
constexpr size_t WS_BAR = 16384;
constexpr size_t WS_MOD = 32768;
constexpr size_t WS_GATES = WS_MOD + 245760;
constexpr size_t WS_ROPE = WS_GATES + 524288;
constexpr size_t WS_WG = WS_ROPE + 16384;
constexpr size_t WS_CSW = WS_WG + 131072;
constexpr size_t WS_DFTC = WS_CSW + 524288;
constexpr size_t WS_DFTL = WS_DFTC + 262144;
constexpr size_t WS_WINT = WS_DFTL + 4194304;
constexpr size_t WS_WOUTT = WS_WINT + 50331648;
constexpr size_t WS_H = WS_WOUTT + 16777216;
constexpr size_t WS_Z = WS_H + 33554432;
constexpr size_t WS_Q = WS_Z + 100663296;
constexpr size_t WS_K = WS_Q + 16777216;
constexpr size_t WS_V = WS_K + 8388608;
constexpr size_t WS_MQ = WS_V + 8388608;
constexpr size_t WS_X1B = WS_MQ;
constexpr size_t WS_MK = WS_MQ + 8388608;
constexpr size_t WS_MKT = WS_MK + 8388608;
constexpr size_t WS_MVT = WS_MKT + 8388608;
constexpr size_t WS_XT = WS_MVT + 8388608;
constexpr size_t WS_GS = WS_XT + 8388608;
constexpr size_t WS_DEC = WS_GS + 1310720;
constexpr size_t WS_U = WS_DEC + 4096;
constexpr size_t WS_UN = WS_U + 67108864;
constexpr size_t WS_CJ = WS_UN + 524288;
constexpr size_t WS_NJ = WS_CJ + 33554432;
constexpr size_t WS_END = WS_NJ + 524288;
constexpr int KC_ELEMS = 16 * 2 * 256 * 128;
constexpr int KL_ELEMS = 4 * 2 * 1536 * 128;
constexpr int LDS_MISC = 151552;
constexpr int LDS_BYTES = LDS_MISC + 256;

struct P { const float* in[21]; float* out; unsigned char* ws; };
enum { I_XP = 0, I_XS, I_CK, I_CV, I_SC, I_SN, I_SM, I_C, I_CCTX, I_NORMW, I_WMOD, I_BMOD, I_WIN, I_BIF, I_CONVW, I_CONVB, I_QN, I_KN, I_MLN, I_WFNO, I_WOUT };

DI unsigned pk2(float lo, float hi) { unsigned r; asm volatile("v_cvt_pk_bf16_f32 %0, %1, %2" : "=v"(r) : "v"(lo), "v"(hi)); return r; }
DI float bf2f(bf16_t v) { return __uint_as_float(((unsigned)v) << 16); }
DI float bfs2f(short v) { return __uint_as_float(((unsigned)(unsigned short)v) << 16); }
DI bf16_t f2bf(float f) { unsigned r; asm("v_cvt_pk_bf16_f32 %0, %1, %1" : "=v"(r) : "v"(f)); return (bf16_t)r; }
typedef __bf16 bf16x2_t __attribute__((ext_vector_type(2)));
DI float dot2bf(unsigned a, unsigned b, float c) { return __builtin_amdgcn_fdot2_f32_bf16(__builtin_bit_cast(bf16x2_t, a), __builtin_bit_cast(bf16x2_t, b), c, false); }
DI float wave_sum(float v) {
#pragma unroll
    for (int o = 1; o < 64; o <<= 1) v += __shfl_xor(v, o);
    return v;
}
DI float silu_f(float x) { return x * __builtin_amdgcn_rcpf(1.f + __expf(-x)); }
DI float sigm_f(float x) { return __builtin_amdgcn_rcpf(1.f + __expf(-x)); }
DI int crow(int reg, int h) { return (reg & 3) + 8 * (reg >> 2) + 4 * h; }
DI bf16x8 pack8(const float* v) { u32x4 w; w.x = pk2(v[0], v[1]); w.y = pk2(v[2], v[3]); w.z = pk2(v[4], v[5]); w.w = pk2(v[6], v[7]); return __builtin_bit_cast(bf16x8, w); }

DI void transpose_item(const float* W, int ldw, int K, bf16_t* WT, int k0, int col_src, int row_dst, LAS float* scr, int lane) {
#pragma unroll 16
    for (int i = 0; i < 32; ++i) { const int kk = 2 * i + (lane >> 5); scr[kk * 33 + (lane & 31)] = __builtin_nontemporal_load(&W[(size_t)(k0 + kk) * ldw + col_src + (lane & 31)]); }
    asm volatile("s_waitcnt lgkmcnt(0)" ::: "memory");
    const int c = lane & 7;
#pragma unroll
    for (int j = 0; j < 4; ++j) { const int n = (lane >> 3) + 8 * j; const LAS float* s = scr + (8 * c) * 33 + n;
        u32x4 o; o.x = pk2(s[0 * 33], s[1 * 33]); o.y = pk2(s[2 * 33], s[3 * 33]); o.z = pk2(s[4 * 33], s[5 * 33]); o.w = pk2(s[6 * 33], s[7 * 33]);
        *(u32x4*)(WT + (size_t)(row_dst + n) * K + k0 + 8 * c) = o; }
    asm volatile("s_waitcnt lgkmcnt(0)" ::: "memory");
}

DI void phase0(const P& p, LAS unsigned char* lds, int ctr_idx) {
    TID_SETUP
    unsigned char* ws = p.ws;
    const int G = gridDim.x, bid = blockIdx.x;
    const int gt = bid * 512 + tid, NT = G * 512;
    {
        float* rope = (float*)(ws + WS_ROPE);
        for (int i = gt; i < 2048; i += NT) { const int pos = i >> 5, f = i & 31; const float inv = exp2f(-(float)f * (13.287712379549449f / 32.f));
            float s, c; sincosf((float)pos * inv, &s, &c); rope[2 * i] = c; rope[2 * i + 1] = s; }
        bf16_t* dc = (bf16_t*)(ws + WS_DFTC);
        for (int i = gt; i < 65536; i += NT) { const int a = i >> 8, b = i & 255, m = (a * b) & 255; float s, c; sincospif((float)m * (2.f / 256.f), &s, &c);
            const float sc = 0.005524271728019903f; dc[i] = f2bf(c * sc); dc[65536 + i] = f2bf(s * sc); }
        bf16_t* dl = (bf16_t*)(ws + WS_DFTL);
        for (int i = gt; i < 1048576; i += NT) { const int a = i >> 10, b = i & 1023, m = (a * b) & 1023; float s, c; sincospif((float)m * (2.f / 1024.f), &s, &c);
            const float sc = 0.0027621358640099515f; dl[i] = f2bf(c * sc); dl[1048576 + i] = f2bf(s * sc); }
        bf16_t* wg = (bf16_t*)(ws + WS_WG); const float* win = p.in[I_WIN];
        for (int i = gt; i < 65536; i += NT) { const int l = i >> 15, n = (i >> 11) & 15, k = i & 2047; wg[i] = f2bf(win[((size_t)l * 2048 + k) * 6160 + 5120 + n]); }
        const float* ck = p.in[I_CK]; const float* cv = p.in[I_CV];
        bf16_t* Kb = (bf16_t*)(ws + WS_K) + KC_ELEMS; bf16_t* Vb = (bf16_t*)(ws + WS_V) + KC_ELEMS;
        for (int i = gt; i < 131072; i += NT) { const int d8 = i & 15, key = (i >> 4) & 511, kvh = (i >> 13) & 1, b = (i >> 14) & 3, l = i >> 16;
            const size_t src = ((((size_t)b * 2 + l) * 512 + key) * 2 + kvh) * 128 + d8 * 8;
            const size_t dst = (size_t)l * KL_ELEMS + ((size_t)(b * 2 + kvh) * 1536 + key) * 128 + d8 * 8;
            const f32x4 a0 = *(const f32x4*)(ck + src), a1 = *(const f32x4*)(ck + src + 4), b0 = *(const f32x4*)(cv + src), b1 = *(const f32x4*)(cv + src + 4);
            u32x4 wk_, wv_; wk_.x = pk2(a0[0], a0[1]); wk_.y = pk2(a0[2], a0[3]); wk_.z = pk2(a1[0], a1[1]); wk_.w = pk2(a1[2], a1[3]);
            wv_.x = pk2(b0[0], b0[1]); wv_.y = pk2(b0[2], b0[3]); wv_.z = pk2(b1[0], b1[1]); wv_.w = pk2(b1[2], b1[3]);
            *(u32x4*)(Kb + dst) = wk_; *(u32x4*)(Vb + dst) = wv_; }
    }
    for (int u = bid; u < 256; u += G) {
        const int lg = u >> 5, jr = u & 31;
        LAS float* Wl = (LAS float*)lds; LAS float* ct = (LAS float*)(lds + 65536);
        const float* wf = p.in[I_WFNO] + (size_t)lg * 16384;
        for (int i = tid; i < 4096; i += 512) ((LAS f32x4*)Wl)[i] = ((const f32x4*)wf)[i];
        if (tid < 128) ct[tid] = cospif((float)tid * (1.f / 64.f));
        __syncthreads();
        bf16_t* csw = (bf16_t*)(ws + WS_CSW);
#pragma unroll
        for (int i = 0; i < 2; ++i) { const int e = tid + 512 * i, d = e & 127, j = 8 * jr + (e >> 7); const int c = j & 127, sh = (j >= 128) ? 32 : 0;
            float acc = 0.f;
#pragma unroll 8
            for (int cp = 0; cp < 128; ++cp) acc += ct[((c * cp) - sh) & 127] * Wl[cp * 128 + d];
            csw[((size_t)lg * 128 + d) * 256 + j] = f2bf(sh ? -acc : acc); }
        __syncthreads();
    }
    for (int t = bid; t < 192; t += G) {
        const int l = t / 96, col0 = (t % 96) * 64;
        LAS float* sc = (LAS float*)lds; LAS float* red = (LAS float*)(lds + 40960);
        for (int i = tid; i < 5 * 2048; i += 512) { const int ci = i >> 11, k = i & 2047; const float cvv = ci == 0 ? p.in[I_CCTX][k] : p.in[I_C][(ci - 1) * 2048 + k]; sc[i] = cvv / (1.f + expf(-cvv)); }
        __syncthreads();
        const int cq = lane & 15, kr = lane >> 4;
        const float* wp = p.in[I_WMOD] + (size_t)l * 2048 * 6144 + col0 + 4 * cq;
        f32x4 acc[5];
#pragma unroll
        for (int ci = 0; ci < 5; ++ci) acc[ci] = (f32x4){0.f, 0.f, 0.f, 0.f};
#pragma unroll 8
        for (int it = 0; it < 64; ++it) { const int k = wave * 4 + kr + 32 * it; const f32x4 wv = __builtin_nontemporal_load((const f32x4*)(wp + (size_t)k * 6144));
#pragma unroll
            for (int ci = 0; ci < 5; ++ci) acc[ci] += wv * sc[ci * 2048 + k]; }
#pragma unroll
        for (int ci = 0; ci < 5; ++ci)
#pragma unroll
            for (int j = 0; j < 4; ++j) { float v = acc[ci][j]; v += __shfl_xor(v, 16); v += __shfl_xor(v, 32); if (kr == 0) red[(wave * 20 + ci * 4 + j) * 16 + cq] = v; }
        __syncthreads();
        if (tid < 320) { const int ci = tid >> 6, cc = tid & 63, cq2 = cc >> 2, j = cc & 3; float s = 0.f;
#pragma unroll
            for (int w = 0; w < 8; ++w) s += red[(w * 20 + ci * 4 + j) * 16 + cq2];
            ((float*)(ws + WS_MOD))[(size_t)(l * 5 + ci) * 6144 + col0 + cc] = s + p.in[I_BMOD][l * 6144 + col0 + cc]; }
        __syncthreads();
    }
    {
        LAS float* scr = (LAS float*)(lds + wave * 8448);
        unsigned* ctr = (unsigned*)(ws + WS_CTL) + ctr_idx;
        for (;;) {
            unsigned base = 0; if (lane == 0) base = atomicAdd(ctr, 8u); base = __builtin_amdgcn_readfirstlane(base);
            if (base >= 16384u) break;
#pragma unroll 1
            for (unsigned q = 0; q < 8; ++q) { const unsigned it = base + q;
                if (it < 12288u) { const int l = it / 6144, r = it % 6144, kb = r / 192, nb = r % 192; const int n0 = nb * 32;
                    transpose_item(p.in[I_WIN] + (size_t)l * 2048 * 6160, 6160, 2048, (bf16_t*)(ws + WS_WINT) + (size_t)l * 6144 * 2048, kb * 64, n0 + (n0 >= 5120 ? 16 : 0), n0, scr, lane); }
                else { const int r0 = it - 12288, l = r0 / 2048, r = r0 % 2048, kb = r / 64, nb = r % 64;
                    transpose_item(p.in[I_WOUT] + (size_t)l * 2048 * 2048, 2048, 2048, (bf16_t*)(ws + WS_WOUTT) + (size_t)l * 2048 * 2048, kb * 64, nb * 32, nb * 32, scr, lane); } }
        }
    }
}

DI void phaseA(const P& p, LAS unsigned char* lds, int layer) {
    TID_SETUP
    unsigned char* ws = p.ws;
    {
        const u32x4* src = (const u32x4*)((const bf16_t*)(ws + WS_WG) + (size_t)layer * 32768);
        for (int i = tid; i < 4096; i += 512) ((LAS u32x4*)lds)[i] = src[i];
    }
    __syncthreads();
    const float* modl = (const float*)(ws + WS_MOD) + (size_t)layer * 5 * 6144;
    const float* nw = p.in[I_NORMW] + layer * 2048;
    bf16_t* H = (bf16_t*)(ws + WS_H); float* gates = (float*)(ws + WS_GATES);
    const int gw = blockIdx.x * 8 + wave, NGW = gridDim.x * 8;
#define A_LOAD(dst, row) do { const int r_ = (row); \
        if (layer == 0) { const float* xr_ = r_ < 4096 ? p.in[I_XP] + (size_t)r_ * 2048 : p.in[I_XS] + (size_t)(r_ - 4096) * 2048; \
            _Pragma("unroll") for (int j = 0; j < 8; ++j) dst[j] = __builtin_nontemporal_load((const f32x4*)(xr_ + 4 * lane + 256 * j)); } \
        else { const bf16_t* xr_ = (const bf16_t*)(ws + WS_X1B) + (size_t)r_ * 2048; \
            _Pragma("unroll") for (int j = 0; j < 8; ++j) { const u32x2 w_ = *(const u32x2*)(xr_ + 4 * lane + 256 * j); \
                dst[j][0] = __uint_as_float(w_.x << 16); dst[j][1] = __uint_as_float(w_.x & 0xffff0000u); dst[j][2] = __uint_as_float(w_.y << 16); dst[j][3] = __uint_as_float(w_.y & 0xffff0000u); } } } while (0)
    for (int m = gw; m < NTOK; m += NGW) {
        f32x4 xv[8]; A_LOAD(xv, m);
        const int ci = m < 4096 ? 0 : 1 + ((m - 4096) >> 10);
        const float* shp = modl + ci * 6144; const float* scp = shp + 2048;
        float ss = 0.f;
#pragma unroll
        for (int j = 0; j < 8; ++j) ss += (xv[j][0] * xv[j][0] + xv[j][1] * xv[j][1]) + (xv[j][2] * xv[j][2] + xv[j][3] * xv[j][3]);
        const float rstd = rsqrtf(wave_sum(ss) * (1.f / 2048.f) + EPS);
        float ga[16];
#pragma unroll
        for (int n = 0; n < 16; ++n) ga[n] = 0.f;
#pragma unroll
        for (int j = 0; j < 8; ++j) { const int k = 4 * lane + 256 * j;
            const f32x4 w4 = *(const f32x4*)(nw + k), sh = *(const f32x4*)(shp + k), sc = *(const f32x4*)(scp + k);
            f32x4 v = xv[j] * rstd * w4 * (sc + 1.f) + sh;
            u32x2 o; o.x = pk2(v[0], v[1]); o.y = pk2(v[2], v[3]);
            *(u32x2*)(H + (size_t)m * 2048 + k) = o;
#pragma unroll
            for (int n = 0; n < 16; ++n) { const u32x2 w = *(const LAS u32x2*)(lds + (size_t)(n * 2048 + k) * 2);
                ga[n] = dot2bf(o.y, w.y, dot2bf(o.x, w.x, ga[n])); } }
        float mine = 0.f;
#pragma unroll
        for (int n = 0; n < 16; ++n) { const float s = wave_sum(ga[n]); mine = (lane == n) ? s : mine; }
        if (lane < 16) gates[(size_t)m * 16 + lane] = mine + p.in[I_BIF][layer * 16 + lane];
    }
#undef A_LOAD
    __syncthreads();
}

DI void phaseB2(const P& p, LAS unsigned char* lds, int layer) {
    TID_SETUP
    unsigned char* ws = p.ws;
    const bf16_t* Z = (const bf16_t*)(ws + WS_Z);
    LAS float* tile = (LAS float*)lds;
    LAS float* rope = (LAS float*)(lds + 36864);
    for (int i = tid; i < 1024; i += 512) ((LAS f32x4*)rope)[i] = ((const f32x4*)(ws + WS_ROPE))[i];
#define B2_DECODE(ITEM, tt, gi, LAT, b, t0, T, tokbase, kind, hd, zcol) \
        const int tt = (ITEM) / 2, gi = (ITEM) % 2; const bool LAT = tt >= 64; \
        const int b = LAT ? (tt - 64) >> 4 : tt >> 2, t0 = LAT ? ((tt - 64) & 15) * 64 : (tt & 3) * 64, T = LAT ? 1024 : 256; const int tokbase = tt * 64; \
        const int kind = gi < 2 ? 1 : gi < 6 ? 3 : gi < 10 ? 4 : gi < 14 ? 5 : 6; \
        const int hd = gi < 2 ? gi : gi < 6 ? gi - 2 : gi < 10 ? gi - 6 : gi < 14 ? gi - 10 : gi - 14; \
        const int zcol = (kind == 0 ? ZQ : kind == 1 ? ZK : kind == 2 ? ZV : kind == 3 ? ZMQ : kind == 4 ? ZMK : kind == 5 ? ZMV : ZFX) + hd * 128; (void)b; (void)T; (void)t0;
#define B2_LOAD(tokbase, zcol, kind, t0, T) do { \
        pv0 = *(const bf16x8*)(Z + (size_t)((tokbase) + (tid >> 4)) * NZ + (zcol) + (tid & 15) * 8); \
        pv1 = *(const bf16x8*)(Z + (size_t)((tokbase) + 32 + (tid >> 4)) * NZ + (zcol) + (tid & 15) * 8); \
        ph = (bf16x8){0, 0, 0, 0, 0, 0, 0, 0}; \
        if (((kind) == 3 || (kind) == 4) && tid < 32) { const int tl_ = (tid >> 4) ? 64 : -1; if ((t0) + tl_ >= 0 && (t0) + tl_ < (T)) ph = *(const bf16x8*)(Z + (size_t)((tokbase) + tl_) * NZ + (zcol) + (tid & 15) * 8); } } while (0)
    bf16x8 pv0, pv1, ph;
    if ((int)blockIdx.x < 128 * 2) { B2_DECODE((int)blockIdx.x, tt_, gi_, LAT_, b_, t0_, T_, tokbase_, kind_, hd_, zcol_) (void)hd_; B2_LOAD(tokbase_, zcol_, kind_, t0_, T_); }
    for (int item = blockIdx.x; item < 128 * 2; item += gridDim.x) {
        B2_DECODE(item, tt, gi, LAT, b, t0, T, tokbase, kind, hd, zcol)
        {   const int row = tid >> 4, c8 = (tid & 15) * 8;
#pragma unroll
            for (int jj = 0; jj < 8; ++jj) { tile[(row + 1) * 129 + c8 + jj] = bfs2f(pv0[jj]); tile[(row + 33) * 129 + c8 + jj] = bfs2f(pv1[jj]); }
            if ((kind == 3 || kind == 4) && tid < 32) { const int tl = (tid >> 4) ? 64 : -1;
#pragma unroll
                for (int jj = 0; jj < 8; ++jj) tile[(tl + 1) * 129 + c8 + jj] = bfs2f(ph[jj]); } }
        if (item + (int)gridDim.x < 128 * 2) { B2_DECODE(item + (int)gridDim.x, tt_, gi_, LAT_, b_, t0_, T_, tokbase_, kind_, hd_, zcol_) (void)hd_; B2_LOAD(tokbase_, zcol_, kind_, t0_, T_); }
        __syncthreads();
        if (kind <= 1) {
            const float* nwp = (kind == 0 ? p.in[I_QN] : p.in[I_KN]) + layer * 128;
            const int dA = lane < 32 ? lane : lane + 32, dB = dA + 32;
            const float wA = nwp[dA], wB = nwp[dB];
#pragma unroll
            for (int rr = 0; rr < 8; ++rr) { const int row = wave * 8 + rr;
                float xA = tile[(row + 1) * 129 + dA], xB = tile[(row + 1) * 129 + dB];
                const float rstd = rsqrtf(wave_sum(xA * xA + xB * xB) * (1.f / 128.f) + EPS);
                float yA = xA * rstd * wA, yB = xB * rstd * wB;
                if (LAT) { const int pos = lane < 32 ? (t0 >> 6) : row; const float c = rope[2 * (pos * 32 + (lane & 31))], s = rope[2 * (pos * 32 + (lane & 31)) + 1];
                    const float a = yA * c - yB * s, bb = yA * s + yB * c; yA = a; yB = bb; }
                tile[(row + 1) * 129 + dA] = yA; tile[(row + 1) * 129 + dB] = yB; }
            __syncthreads();
        } else if (kind == 3 || kind == 4) {
            const int cc0 = (kind == 3 ? 0 : 512) + hd * 128;
            const float* cw = p.in[I_CONVW] + (size_t)layer * 3 * 1024 + cc0; const float* cb = p.in[I_CONVB] + layer * 1024 + cc0;
            const int c = tid & 127; const float w0 = cw[c], w1 = cw[1024 + c], w2 = cw[2048 + c], bb = cb[c]; const float osc = kind == 4 ? 0.08838834764831845f : 1.f;
            float vals[16];
#pragma unroll
            for (int i = 0; i < 16; ++i) { const int row = (tid >> 7) + 4 * i; const float v = w0 * tile[row * 129 + c] + w1 * tile[(row + 1) * 129 + c] + w2 * tile[(row + 2) * 129 + c] + bb; vals[i] = silu_f(v) * osc; }
            __syncthreads();
#pragma unroll
            for (int i = 0; i < 16; ++i) { const int row = (tid >> 7) + 4 * i; tile[(row + 1) * 129 + c] = vals[i]; }
            __syncthreads();
        }
        if (kind <= 4) {
            bf16_t* dst;
            if (kind == 0) dst = (bf16_t*)(ws + WS_Q) + (LAT ? (size_t)4096 * 1024 : 0) + ((size_t)(b * 8 + hd) * T + t0) * 128;
            else if (kind == 1 || kind == 2) { bf16_t* base = (bf16_t*)(ws + (kind == 1 ? WS_K : WS_V));
                dst = LAT ? base + KC_ELEMS + (size_t)layer * KL_ELEMS + ((size_t)(b * 2 + hd) * 1536 + 512 + t0) * 128 : base + ((size_t)(b * 2 + hd) * 256 + t0) * 128; }
            else dst = (bf16_t*)(ws + (kind == 3 ? WS_MQ : WS_MK)) + (LAT ? (size_t)4096 * 512 : 0) + ((size_t)(b * 4 + hd) * T + t0) * 128;
#pragma unroll
            for (int i = 0; i < 2; ++i) { const int ch = tid + 512 * i, row = ch >> 4, c8 = (ch & 15) * 8; float v[8];
#pragma unroll
                for (int j = 0; j < 8; ++j) v[j] = tile[(row + 1) * 129 + c8 + j];
                *(bf16x8*)(dst + (size_t)row * 128 + c8) = pack8(v); }
        }
        if (kind >= 4) {
            bf16_t* dst = (bf16_t*)(ws + (kind == 4 ? WS_MKT : (kind == 5 ? WS_MVT : WS_XT))) + (LAT ? (size_t)4096 * 512 : 0) + (size_t)(b * 4 + hd) * 128 * T + t0;
#pragma unroll
            for (int i = 0; i < 2; ++i) { const int ch = tid + 512 * i, c = ch & 127, t8 = (ch >> 7) * 8; float v[8];
#pragma unroll
                for (int j = 0; j < 8; ++j) v[j] = tile[(t8 + j + 1) * 129 + c];
                *(bf16x8*)(dst + (size_t)c * T + t8) = pack8(v); }
        }
        if (!LAT && (kind == 1 || kind == 2)) {
            float* o = p.out + (kind == 1 ? O_NK : O_NV);
#pragma unroll
            for (int i = 0; i < 4; ++i) { const int ch = tid + 512 * i, row = ch >> 5, c4 = (ch & 31) * 4;
                f32x4 v; v[0] = tile[(row + 1) * 129 + c4]; v[1] = tile[(row + 1) * 129 + c4 + 1]; v[2] = tile[(row + 1) * 129 + c4 + 2]; v[3] = tile[(row + 1) * 129 + c4 + 3];
                *(f32x4*)(o + ((((size_t)b * 2 + layer) * 256 + t0 + row) * 2 + hd) * 128 + c4) = v; }
        }
        __syncthreads();
    }
}

DI float scan_add(float x, int lane, bool rev) {
#pragma unroll
    for (int o = 1; o < 64; o <<= 1) { const float v = rev ? __shfl_down(x, o) : __shfl_up(x, o); const bool ok = rev ? (lane + o < 64) : (lane >= o); if (ok) x += v; }
    return x;
}
DI float scan_max(float x, int lane, bool rev) {
#pragma unroll
    for (int o = 1; o < 64; o <<= 1) { const float v = rev ? __shfl_down(x, o) : __shfl_up(x, o); const bool ok = rev ? (lane + o < 64) : (lane >= o); if (ok) x = fmaxf(x, v); }
    return x;
}

DI att::s16x4 xtr(int addr) { att::s16x4 r; asm volatile("ds_read_b64_tr_b16 %0, %1" : "=&v"(r) : "v"(addr) : "memory"); return r; }
DI bf16x8 trfrag(int addr) {
    att::s16x4 l, h;
    asm volatile("ds_read_b64_tr_b16 %0, %2\n\tds_read_b64_tr_b16 %1, %2 offset:2048\n\ts_waitcnt lgkmcnt(0)" : "=&v"(l), "=&v"(h) : "v"(addr) : "memory");
    return (bf16x8){l[0], l[1], l[2], l[3], h[0], h[1], h[2], h[3]}; }
DI void trfrag3(bf16x8& f0, bf16x8& f1, bf16x8& f2, int a0, int a1, int a2) {
    att::s16x4 l0, h0, l1, h1, l2, h2;
    asm volatile("ds_read_b64_tr_b16 %0, %6\n\tds_read_b64_tr_b16 %1, %6 offset:2048\n\tds_read_b64_tr_b16 %2, %7\n\tds_read_b64_tr_b16 %3, %7 offset:2048\n\tds_read_b64_tr_b16 %4, %8\n\tds_read_b64_tr_b16 %5, %8 offset:2048\n\ts_waitcnt lgkmcnt(0)"
                 : "=&v"(l0), "=&v"(h0), "=&v"(l1), "=&v"(h1), "=&v"(l2), "=&v"(h2) : "v"(a0), "v"(a1), "v"(a2) : "memory");
    f0 = (bf16x8){l0[0], l0[1], l0[2], l0[3], h0[0], h0[1], h0[2], h0[3]}; f1 = (bf16x8){l1[0], l1[1], l1[2], l1[3], h1[0], h1[1], h1[2], h1[3]}; f2 = (bf16x8){l2[0], l2[1], l2[2], l2[3], h2[0], h2[1], h2[2], h2[3]}; }
DI void trfrag2(bf16x8& f0, bf16x8& f1, int a0, int a1) {
    att::s16x4 l0, h0, l1, h1;
    asm volatile("ds_read_b64_tr_b16 %0, %4\n\tds_read_b64_tr_b16 %1, %4 offset:2048\n\tds_read_b64_tr_b16 %2, %5\n\tds_read_b64_tr_b16 %3, %5 offset:2048\n\ts_waitcnt lgkmcnt(0)"
                 : "=&v"(l0), "=&v"(h0), "=&v"(l1), "=&v"(h1) : "v"(a0), "v"(a1) : "memory");
    f0 = (bf16x8){l0[0], l0[1], l0[2], l0[3], h0[0], h0[1], h0[2], h0[3]}; f1 = (bf16x8){l1[0], l1[1], l1[2], l1[3], h1[0], h1[1], h1[2], h1[3]}; }
struct Conv8 { f32x4 w[3][2]; f32x4 b[2]; };
DI void conv8_load(Conv8& c, const float* cw, const float* cb) {
#pragma unroll
    for (int j = 0; j < 3; ++j) { c.w[j][0] = *(const f32x4*)(cw + j * 1024); c.w[j][1] = *(const f32x4*)(cw + j * 1024 + 4); }
    c.b[0] = *(const f32x4*)cb; c.b[1] = *(const f32x4*)(cb + 4);
}
DI void conv8_apply(float (&o)[8], const Conv8& c, const bf16_t* zrow, bool has_prev, bool has_next, float osc) {
    const bf16x8 z8 = {0, 0, 0, 0, 0, 0, 0, 0};
    const bf16x8 x1 = *(const bf16x8*)zrow; bf16x8 x0 = z8, x2 = z8;
    if (has_prev) x0 = *(const bf16x8*)(zrow - NZ);
    if (has_next) x2 = *(const bf16x8*)(zrow + NZ);
#pragma unroll
    for (int j = 0; j < 8; ++j) { const float v = c.w[0][j >> 2][j & 3] * bfs2f(x0[j]) + c.w[1][j >> 2][j & 3] * bfs2f(x1[j]) + c.w[2][j >> 2][j & 3] * bfs2f(x2[j]) + c.b[j >> 2][j & 3]; o[j] = silu_f(v) * osc; }
}
template <bool LAT>
DI void gate_scan_block(const P& p, LAS unsigned char* lds, int layer, int b, int head, int dir) {
    TID_SETUP
    constexpr int T = LAT ? 1024 : 256, NCH = T / 64;
    unsigned char* ws = p.ws;
    const int tok0 = LAT ? 4096 + b * 1024 : b * 256;
    const int sidx = ((b * 2 + layer) * 2 + dir) * 4 + head;
    const float m0 = LAT ? p.in[I_SM][sidx] : 0.f;
    float* GS = (float*)(ws + WS_GS) + (size_t)(dir * 4 + head) * NTOK;
    float* DEC = (float*)(ws + WS_DEC) + (dir * 4 + head) * 128;
    const float* gates = (const float*)(ws + WS_GATES);
    LAS float* bl_l = (LAS float*)lds; LAS float* am_l = bl_l + 16;
    float a_r[2], bc_r[2], am_r[2];
#pragma unroll
    for (int q = 0; q < 2; ++q) { const int it = wave + 8 * q; a_r[q] = 0.f; bc_r[q] = 0.f; am_r[q] = 0.f;
        if (it < NCH) { const int cj = dir ? NCH - 1 - it : it; const float* gr = gates + (size_t)(tok0 + cj * 64 + lane) * 16;
            const float giv = gr[(dir ? 8 : 0) + head], gfv = gr[(dir ? 12 : 4) + head];
            const float lf = fminf(gfv, 0.f) - log1pf(expf(-fabsf(gfv)));
            const float bc = scan_add(lf, lane, dir != 0); const float a = giv - bc; const float am = scan_max(a, lane, dir != 0);
            const int last = dir ? 0 : 63;
            const float blast = __shfl(bc, last), amall = __shfl(am, last);
            if (lane == 0) { bl_l[it] = blast; am_l[it] = amall; }
            a_r[q] = a; bc_r[q] = bc; am_r[q] = am; } }
    __syncthreads();
#pragma unroll
    for (int q = 0; q < 2; ++q) { const int it = wave + 8 * q;
        if (it < NCH) { const int cj = dir ? NCH - 1 - it : it; const int tok = tok0 + cj * 64 + lane;
            float m = m0; for (int k = 0; k < it; ++k) m = bl_l[k] + fmaxf(m, am_l[k]);
            const float M = fmaxf(m, am_r[q]), Mall = fmaxf(m, am_l[it]);
            GS[tok] = a_r[q]; GS[65536 + tok] = M; GS[2 * 65536 + tok] = expf(m - M); GS[3 * 65536 + tok] = expf(-(bc_r[q] + M)); GS[4 * 65536 + tok] = expf(a_r[q] - Mall);
            if (lane == 0) DEC[(tok0 >> 6) + cj] = expf(m - Mall);
            if (!LAT && it == NCH - 1 && lane == 0) p.out[O_NM + sidx] = bl_l[it] + Mall; } }
    __syncthreads();
}

DI void gate_scan_phase(const P& p, LAS unsigned char* lds, int layer) {
    for (int s = blockIdx.x; s < 160; s += gridDim.x) {
        if (s < 128) gate_scan_block<false>(p, lds, layer, s >> 3, (s >> 1) & 3, s & 1);
        else gate_scan_block<true>(p, lds, layer, (s - 128) >> 3, (s >> 1) & 3, s & 1); }
}

struct M1Rows { bf16x8 v[2], k0[2], k1[2], k2[2]; float w0[2], w1[2]; };
DI void m1_rows_load(M1Rows& R, const bf16_t* Z, const float* WK0, const float* WK1, int t0, int T, int tid) {
    const bf16x8 z8 = {0, 0, 0, 0, 0, 0, 0, 0}; const int c8 = (tid & 15) * 8;
#pragma unroll
    for (int i = 0; i < 2; ++i) { const int row = (tid >> 4) + 32 * i; const bf16_t* zr = Z + (size_t)row * NZ;
        R.v[i] = *(const bf16x8*)(zr + ZMV + c8); R.k1[i] = *(const bf16x8*)(zr + ZMK + c8);
        R.k0[i] = (t0 + row > 0) ? *(const bf16x8*)(zr - NZ + ZMK + c8) : z8; R.k2[i] = (t0 + row < T - 1) ? *(const bf16x8*)(zr + NZ + ZMK + c8) : z8;
        R.w0[i] = WK0[row]; R.w1[i] = WK1[row]; }
}
DI void m1_group(const P& p, LAS unsigned char* lds, int layer, int gidx) {
    TID_SETUP
    unsigned char* ws = p.ws;
    const int id0 = gidx * 4; const bool LAT = id0 >= 256; const int u0 = LAT ? id0 - 256 : id0;
    const int b = LAT ? u0 >> 6 : u0 >> 4, head = LAT ? (u0 >> 4) & 3 : (u0 >> 2) & 3, chunk0 = LAT ? u0 & 15 : u0 & 3;
    const int T = LAT ? 1024 : 256, tok0 = LAT ? 4096 + b * 1024 : b * 256;
    const int c8 = (tid & 15) * 8;
    Conv8 cv; conv8_load(cv, p.in[I_CONVW] + (size_t)layer * 3072 + 512 + head * 128 + c8, p.in[I_CONVB] + layer * 1024 + 512 + head * 128 + c8);
    const bf16_t* Zh = (const bf16_t*)(ws + WS_Z) + (size_t)tok0 * NZ + head * 128;
    const float* WKh = (const float*)(ws + WS_GS) + (size_t)4 * 65536 + (size_t)head * NTOK + tok0;
    const int r = lane & 31, hl = lane >> 5, eb4 = wave >> 1, dh = wave & 1;
    const int vb = (int)(unsigned)(size_t)lds + att::v_rd_base(lane);
    const bf16x8 ones = {0x3F80, 0x3F80, 0x3F80, 0x3F80, 0x3F80, 0x3F80, 0x3F80, 0x3F80};
    M1Rows R; { const int t0 = chunk0 * 64; m1_rows_load(R, Zh + (size_t)t0 * NZ, WKh + t0, WKh + (size_t)4 * NTOK + t0, t0, T, tid); }
#pragma unroll 1
    for (int q = 0; q < 4; ++q) {
        const int t0 = (chunk0 + q) * 64;
#pragma unroll
        for (int i = 0; i < 2; ++i) { const int row = (tid >> 4) + 32 * i; const int st = att::v_st(row, c8);
            *(LAS bf16x8*)(lds + st) = R.v[i];
            float kv[8], k2[8];
#pragma unroll
            for (int e = 0; e < 8; ++e) { const float cvv = cv.w[0][e >> 2][e & 3] * bfs2f(R.k0[i][e]) + cv.w[1][e >> 2][e & 3] * bfs2f(R.k1[i][e]) + cv.w[2][e >> 2][e & 3] * bfs2f(R.k2[i][e]) + cv.b[e >> 2][e & 3];
                const float kk = silu_f(cvv) * 0.08838834764831845f; kv[e] = kk * R.w0[i]; k2[e] = kk * R.w1[i]; }
            *(LAS bf16x8*)(lds + 16384 + st) = pack8(kv); *(LAS bf16x8*)(lds + 32768 + st) = pack8(k2); }
        __syncthreads();
        if (q < 3) { const int t1 = t0 + 64; m1_rows_load(R, Zh + (size_t)t1 * NZ, WKh + t1, WKh + (size_t)4 * NTOK + t1, t1, T, tid); }
#pragma unroll 1
        for (int dir = 0; dir < 2; ++dir) {
            const int kb = vb + 16384 + dir * 16384;
            const int cd = (dir * 4 + head) * 128 + ((tok0 + t0) >> 6);
            f32x16 acc[2], accn[2];
#pragma unroll
            for (int i = 0; i < 16; ++i) { acc[0][i] = 0.f; acc[1][i] = 0.f; accn[0][i] = 0.f; accn[1][i] = 0.f; }
#pragma unroll
            for (int ks = 0; ks < 4; ++ks) {
                bf16x8 vf, kf[2]; trfrag3(vf, kf[0], kf[1], vb + eb4 * 512 + ks * 4096, kb + (2 * dh) * 512 + ks * 4096, kb + (2 * dh + 1) * 512 + ks * 4096);
                __builtin_amdgcn_s_setprio(1);
#pragma unroll
                for (int db = 0; db < 2; ++db) { acc[db] = MFMA32(vf, kf[db], acc[db]);
                    if (eb4 == 0) accn[db] = MFMA32(ones, kf[db], accn[db]); }
                __builtin_amdgcn_s_setprio(0);
            }
            bf16_t* U = (bf16_t*)(ws + WS_U) + (size_t)cd * 16384;
#pragma unroll
            for (int db = 0; db < 2; ++db)
#pragma unroll
                for (int i = 0; i < 16; ++i) U[(32 * eb4 + crow(i, hl)) * 128 + 64 * dh + 32 * db + r] = f2bf(acc[db][i]);
            if (eb4 == 0 && hl == 0) { float* UN = (float*)(ws + WS_UN) + (size_t)cd * 128 + 64 * dh + r; UN[0] = accn[0][0]; UN[32] = accn[1][0]; }
        }
        __syncthreads();
    }
}

template <bool LAT>
DI void m2_unit(const P& p, int layer, int b, int head, int dir, int eg) {
    TID_SETUP
    constexpr int T = LAT ? 1024 : 256, NCH = T / 64;
    unsigned char* ws = p.ws;
    const int tok0 = LAT ? 4096 + b * 1024 : b * 256;
    const int sidx = ((b * 2 + layer) * 2 + dir) * 4 + head;
    const int cdbase = (dir * 4 + head) * 128 + (tok0 >> 6);
    const float* DEC = (const float*)(ws + WS_DEC);
    const int ebase = eg * 2048 + tid;
    float uv[NCH][4], dec[NCH], un[NCH];
#pragma unroll
    for (int it = 0; it < NCH; ++it) { const int cd = cdbase + (dir ? NCH - 1 - it : it); const bf16_t* U = (const bf16_t*)(ws + WS_U) + (size_t)cd * 16384 + ebase;
        dec[it] = DEC[cd];
#pragma unroll
        for (int i = 0; i < 4; ++i) uv[it][i] = bf2f(U[512 * i]);
        un[it] = (eg == 0 && tid < 128) ? ((const float*)(ws + WS_UN))[(size_t)cd * 128 + tid] : 0.f; }
    float C[4];
#pragma unroll
    for (int i = 0; i < 4; ++i) { const int idx = ebase + 512 * i, e = idx >> 7, d = idx & 127; C[i] = LAT ? p.in[I_SC][(size_t)sidx * 16384 + d * 128 + e] : 0.f; }
    float n = 0.f; if (LAT && eg == 0 && tid < 128) n = p.in[I_SN][sidx * 128 + tid];
#pragma unroll
    for (int it = 0; it < NCH; ++it) { const int cd = cdbase + (dir ? NCH - 1 - it : it);
        bf16_t* CJ = (bf16_t*)(ws + WS_CJ) + (size_t)cd * 16384 + ebase;
#pragma unroll
        for (int i = 0; i < 4; ++i) { CJ[512 * i] = f2bf(C[i]); C[i] = dec[it] * C[i] + uv[it][i]; }
        if (eg == 0 && tid < 128) { ((float*)(ws + WS_NJ))[(size_t)cd * 128 + tid] = n; n = dec[it] * n + un[it]; } }
    if (!LAT) {
#pragma unroll
        for (int i = 0; i < 4; ++i) { const int idx = ebase + 512 * i, e = idx >> 7, d = idx & 127; p.out[O_NC + (size_t)sidx * 16384 + d * 128 + e] = C[i]; }
        if (eg == 0 && tid < 128) p.out[O_NN + (size_t)sidx * 128 + tid] = n;
    }
}

template <bool LAT> struct M2Regs { bf16x8 uv[(LAT ? 16 : 4)]; float dec[(LAT ? 16 : 4)]; float un[(LAT ? 16 : 4)]; };
template <bool LAT>
DI void m2_load(const P& p, M2Regs<LAT>& R, int b, int head, int dir, int eg, int tid) {
    constexpr int NCH = LAT ? 16 : 4;
    unsigned char* ws = p.ws;
    const int tok0 = LAT ? 4096 + b * 1024 : b * 256;
    const int cdbase = (dir * 4 + head) * 128 + (tok0 >> 6);
    const int ebase = eg * 4096 + tid * 8;
#pragma unroll
    for (int it = 0; it < NCH; ++it) { const int cd = cdbase + (dir ? NCH - 1 - it : it);
        R.dec[it] = ((const float*)(ws + WS_DEC))[cd];
        R.uv[it] = __builtin_nontemporal_load((const bf16x8*)((const bf16_t*)(ws + WS_U) + (size_t)cd * 16384 + ebase));
        R.un[it] = (eg == 0 && tid < 128) ? ((const float*)(ws + WS_UN))[(size_t)cd * 128 + tid] : 0.f; }
}
template <bool LAT>
DI void m2_run(const P& p, const M2Regs<LAT>& R, int layer, int b, int head, int dir, int eg, int tid) {
    constexpr int NCH = LAT ? 16 : 4;
    unsigned char* ws = p.ws;
    const int tok0 = LAT ? 4096 + b * 1024 : b * 256;
    const int sidx = ((b * 2 + layer) * 2 + dir) * 4 + head;
    const int cdbase = (dir * 4 + head) * 128 + (tok0 >> 6);
    const int ebase = eg * 4096 + tid * 8, e = ebase >> 7, d0 = ebase & 127;
    float C[8];
#pragma unroll
    for (int i = 0; i < 8; ++i) C[i] = LAT ? p.in[I_SC][(size_t)sidx * 16384 + (d0 + i) * 128 + e] : 0.f;
    float n = 0.f; if (LAT && eg == 0 && tid < 128) n = p.in[I_SN][sidx * 128 + tid];
#pragma unroll
    for (int it = 0; it < NCH; ++it) { const int cd = cdbase + (dir ? NCH - 1 - it : it);
        *(bf16x8*)((bf16_t*)(ws + WS_CJ) + (size_t)cd * 16384 + ebase) = pack8(C);
#pragma unroll
        for (int i = 0; i < 8; ++i) C[i] = R.dec[it] * C[i] + bfs2f(R.uv[it][i]);
        if (eg == 0 && tid < 128) { ((float*)(ws + WS_NJ))[(size_t)cd * 128 + tid] = n; n = R.dec[it] * n + R.un[it]; } }
    if (!LAT) {
#pragma unroll
        for (int i = 0; i < 8; ++i) __builtin_nontemporal_store(C[i], &p.out[O_NC + (size_t)sidx * 16384 + (d0 + i) * 128 + e]);
        if (eg == 0 && tid < 128) p.out[O_NN + (size_t)sidx * 128 + tid] = n;
    }
}
DI void m2_block(const P& p, int layer, int slot) {
    TID_SETUP
    M2Regs<false> Rc[2]; M2Regs<true> Rl;
#pragma unroll
    for (int k = 0; k < 2; ++k) { const int u = slot + 256 * k, s = u >> 2; m2_load<false>(p, Rc[k], s >> 3, (s >> 1) & 3, s & 1, u & 3, tid); }
    if (slot < 128) { const int s = slot >> 2; m2_load<true>(p, Rl, s >> 3, (s >> 1) & 3, s & 1, slot & 3, tid); }
#pragma unroll
    for (int k = 0; k < 2; ++k) { const int u = slot + 256 * k, s = u >> 2; m2_run<false>(p, Rc[k], layer, s >> 3, (s >> 1) & 3, s & 1, u & 3, tid); }
    if (slot < 128) { const int s = slot >> 2; m2_run<true>(p, Rl, layer, s >> 3, (s >> 1) & 3, s & 1, slot & 3, tid); }
}

DI void m3_task(const P& p, LAS unsigned char* lds, int layer, int id) {
    TID_SETUP
    unsigned char* ws = p.ws;
    const bool LAT = id >= 256; const int u = LAT ? id - 256 : id;
    const int b = LAT ? u >> 6 : u >> 4, head = LAT ? (u >> 4) & 3 : (u >> 2) & 3, chunk = LAT ? u & 15 : u & 3;
    const int T = LAT ? 1024 : 256, tok0 = LAT ? 4096 + b * 1024 : b * 256, t0 = chunk * 64;
    const int dir = wave >> 2, w4 = wave & 3, td = tid & 255;
    const int cd = (dir * 4 + head) * 128 + ((tok0 + t0) >> 6);
    const float* GS = (const float*)(ws + WS_GS) + (size_t)(dir * 4 + head) * NTOK + tok0 + t0;
    LAS bf16_t* Ql = (LAS bf16_t*)(lds + 98304); LAS bf16_t* Kl = (LAS bf16_t*)(lds + 98304 + 17408); LAS unsigned char* Vimg = lds + 98304 + 34816;
    {   const bf16_t* Zc = (const bf16_t*)(ws + WS_Z) + (size_t)(tok0 + t0) * NZ + head * 128; const int c8 = (tid & 15) * 8;
        Conv8 cq, ck; conv8_load(cq, p.in[I_CONVW] + (size_t)layer * 3072 + head * 128 + c8, p.in[I_CONVB] + layer * 1024 + head * 128 + c8);
        conv8_load(ck, p.in[I_CONVW] + (size_t)layer * 3072 + 512 + head * 128 + c8, p.in[I_CONVB] + layer * 1024 + 512 + head * 128 + c8);
#pragma unroll
        for (int i = 0; i < 2; ++i) { const int row = (tid >> 4) + 32 * i; const bool hp = t0 + row > 0, hn = t0 + row < T - 1; float v8[8];
            conv8_apply(v8, cq, Zc + (size_t)row * NZ + ZMQ + c8, hp, hn, 1.f); *(LAS bf16x8*)(Ql + row * 136 + c8) = pack8(v8);
            conv8_apply(v8, ck, Zc + (size_t)row * NZ + ZMK + c8, hp, hn, 0.08838834764831845f); *(LAS bf16x8*)(Kl + row * 136 + c8) = pack8(v8);
            *(LAS bf16x8*)(Vimg + att::v_st(row, c8)) = __builtin_nontemporal_load((const bf16x8*)(Zc + (size_t)row * NZ + ZMV + c8)); } }
    LAS unsigned char* L = lds + dir * 49152;
    LAS bf16_t* CTl = (LAS bf16_t*)L; LAS bf16_t* Sl = (LAS bf16_t*)(L + 34816); LAS float* vec = (LAS float*)(L + 44032);
    LAS float* Hl = (LAS float*)L;
    LAS float *a_l = vec, *M_l = vec + 64, *wi_l = vec + 128, *emr_l = vec + 192, *dinv_l = vec + 320, *qn_l = vec + 384, *n_l = vec + 640;
    const int r = lane & 31, hl = lane >> 5, wi = w4 >> 1, wj = w4 & 1;
    if (td < 64) { a_l[td] = GS[td]; M_l[td] = GS[65536 + td]; wi_l[td] = GS[2 * 65536 + td]; emr_l[td] = GS[3 * 65536 + td]; }
    if (td >= 128) n_l[td - 128] = ((const float*)(ws + WS_NJ))[(size_t)cd * 128 + td - 128];
    {   const bf16_t* CJ = (const bf16_t*)(ws + WS_CJ) + (size_t)cd * 16384;
#pragma unroll
        for (int i = 0; i < 8; ++i) { const int ch = td + 256 * i, e = ch >> 4, d8 = (ch & 15) * 8; *(LAS bf16x8*)(CTl + e * 136 + d8) = __builtin_nontemporal_load((const bf16x8*)(CJ + e * 128 + d8)); } }
    __syncthreads();
    bf16x8 qf[8];
#pragma unroll
    for (int ks = 0; ks < 8; ++ks) qf[ks] = *(const LAS bf16x8*)(Ql + (32 * wi + r) * 136 + 16 * ks + 8 * hl);
    {   const int pp = td & 63, part = td >> 6; const LAS bf16_t* qp = Ql + pp * 136 + 32 * part; float s = 0.f;
#pragma unroll
        for (int c = 0; c < 4; ++c) { const bf16x8 v = *(const LAS bf16x8*)(qp + 8 * c);
#pragma unroll
            for (int j = 0; j < 8; ++j) s += bfs2f(v[j]) * n_l[32 * part + 8 * c + j]; }
        qn_l[part * 64 + pp] = s; }
    {   f32x16 sacc;
#pragma unroll
        for (int i = 0; i < 16; ++i) sacc[i] = 0.f;
#pragma unroll
        for (int ks = 0; ks < 8; ++ks) { const bf16x8 kf = *(const LAS bf16x8*)(Kl + (32 * wj + r) * 136 + 16 * ks + 8 * hl); sacc = MFMA32(qf[ks], kf, sacc); }
        const int s_ = 32 * wj + r; const float as = a_l[s_];
#pragma unroll
        for (int i = 0; i < 16; ++i) { const int pr = 32 * wi + crow(i, hl); const bool valid = dir ? (s_ >= pr) : (s_ <= pr);
            const float v = valid ? sacc[i] * __expf(as - M_l[pr]) : 0.f;
            Sl[pr * 72 + s_] = f2bf(v); } }
    __syncthreads();
    if (w4 == 0) { float rs = 0.f;
#pragma unroll
        for (int c = 0; c < 8; ++c) { const bf16x8 v = *(const LAS bf16x8*)(Sl + lane * 72 + 8 * c);
#pragma unroll
            for (int j = 0; j < 8; ++j) rs += bfs2f(v[j]); }
        const float qn = (qn_l[lane] + qn_l[64 + lane]) + (qn_l[128 + lane] + qn_l[192 + lane]);
        const float den = wi_l[lane] * qn + rs; dinv_l[lane] = 1.f / fmaxf(fabsf(den), emr_l[lane]); }
    f32x16 nacc[2];
#pragma unroll
    for (int i = 0; i < 16; ++i) { nacc[0][i] = 0.f; nacc[1][i] = 0.f; }
#pragma unroll
    for (int ks = 0; ks < 8; ++ks)
#pragma unroll
        for (int eb = 0; eb < 2; ++eb) { const bf16x8 cf = *(const LAS bf16x8*)(CTl + (64 * wj + 32 * eb + r) * 136 + 16 * ks + 8 * hl); __builtin_amdgcn_s_setprio(1); nacc[eb] = MFMA32(qf[ks], cf, nacc[eb]); __builtin_amdgcn_s_setprio(0); }
#pragma unroll
    for (int i = 0; i < 16; ++i) { const float w = wi_l[32 * wi + crow(i, hl)]; nacc[0][i] *= w; nacc[1][i] *= w; }
#pragma unroll
    for (int ks = 0; ks < 4; ++ks) { const bf16x8 sf = *(const LAS bf16x8*)(Sl + (32 * wi + r) * 72 + 16 * ks + 8 * hl);
        bf16x8 vf[2]; { const int va = (int)(unsigned)(size_t)Vimg + att::v_rd_base(lane) + (2 * wj) * 512 + ks * 4096; trfrag2(vf[0], vf[1], va, va + 512); }
#pragma unroll
        for (int eb = 0; eb < 2; ++eb) nacc[eb] = MFMA32(sf, vf[eb], nacc[eb]); }
    __syncthreads();
#pragma unroll
    for (int i = 0; i < 16; ++i) { const int pr = 32 * wi + crow(i, hl); const float di = dinv_l[pr];
        Hl[pr * 132 + 64 * wj + r] = nacc[0][i] * di; Hl[pr * 132 + 64 * wj + 32 + r] = nacc[1][i] * di; }
    __syncthreads();
    {   const bf16_t* Z = (const bf16_t*)(ws + WS_Z); bf16_t* mix = (bf16_t*)(ws + WS_H);
        const float* mln = p.in[I_MLN] + layer * 512 + head * 128; const float wa = mln[lane], wb = mln[lane + 64];
        LAS float* H0 = (LAS float*)lds; LAS float* H1 = (LAS float*)(lds + 49152);
        float xa[8], xb[8], moa[8], mob[8], mga[8], mgb[8];
#pragma unroll
        for (int rr = 0; rr < 8; ++rr) { const int pr = wave * 8 + rr, tok = tok0 + t0 + pr;
            xa[rr] = H0[pr * 132 + lane] + H1[pr * 132 + lane]; xb[rr] = H0[pr * 132 + 64 + lane] + H1[pr * 132 + 64 + lane];
            const bf16_t* zr = Z + (size_t)tok * NZ + head * 128;
            moa[rr] = bf2f(zr[ZMO + lane]); mob[rr] = bf2f(zr[ZMO + lane + 64]); mga[rr] = bf2f(zr[ZMG + lane]); mgb[rr] = bf2f(zr[ZMG + lane + 64]); }
#pragma unroll
        for (int rr = 0; rr < 8; ++rr) { const int pr = wave * 8 + rr, tok = tok0 + t0 + pr;
            const float rstd = rsqrtf(wave_sum(xa[rr] * xa[rr] + xb[rr] * xb[rr]) * (1.f / 128.f) + EPS);
            bf16_t* mr = mix + (size_t)tok * 2048 + 1024 + head * 128;
            mr[lane] = f2bf(xa[rr] * rstd * wa * sigm_f(moa[rr]) * silu_f(mga[rr])); mr[lane + 64] = f2bf(xb[rr] * rstd * wb * sigm_f(mob[rr]) * silu_f(mgb[rr])); }
    }
    __syncthreads();
}

DI void tile_ld(bf16x8 (&rg)[2], const bf16_t* src, int ld, int tid) {
#pragma unroll
    for (int i = 0; i < 2; ++i) { const int ch = tid + 512 * i, row = ch >> 3, c8 = (ch & 7) * 8; rg[i] = *(const bf16x8*)(src + (size_t)row * ld + c8); }
}
DI void tile_st(LAS bf16_t* dst, const bf16x8 (&rg)[2], int tid) {
#pragma unroll
    for (int i = 0; i < 2; ++i) { const int ch = tid + 512 * i, row = ch >> 3, c8 = (ch & 7) * 8; *(LAS bf16x8*)(dst + row * 72 + c8) = rg[i]; }
}

template <bool LAT>
DI void fourier_task(const P& p, LAS unsigned char* lds, int layer, int b, int g, int tile) {
    TID_SETUP
    constexpr int T = LAT ? 1024 : 256, NKT = T / 64;
    unsigned char* ws = p.ws;
    const bf16_t* DC = (const bf16_t*)(ws + (LAT ? WS_DFTL : WS_DFTC)) + (size_t)tile * 128 * T; const bf16_t* DS = DC + (size_t)T * T;
    const bf16_t* XZ = (const bf16_t*)(ws + WS_Z) + (size_t)(LAT ? 4096 + b * 1024 : b * 256) * NZ + ZFX + g * 128;
    const int wr = wave >> 1, wc = wave & 1, r = lane & 31, hl = lane >> 5;
    const int xs0 = att::v_st(tid >> 4, (tid & 15) * 8), xs1 = att::v_st(32 + (tid >> 4), (tid & 15) * 8);
    const size_t xg0 = (size_t)(tid >> 4) * NZ + (tid & 15) * 8;
    f32x16 aP[2], aQ[2];
#pragma unroll
    for (int i = 0; i < 16; ++i) { aP[0][i] = 0.f; aP[1][i] = 0.f; aQ[0][i] = 0.f; aQ[1][i] = 0.f; }
    const bf16_t* CS = (const bf16_t*)(ws + WS_CSW) + (size_t)(layer * 4 + g) * 128 * 256;
    bf16x8 csr[8];
#pragma unroll
    for (int i = 0; i < 8; ++i) { const int ch = tid + 512 * i; csr[i] = *(const bf16x8*)(CS + (size_t)(ch >> 5) * 256 + (ch & 31) * 8); }
    bf16x8 rcA[2], rsA[2], rxA[2], rcB[2], rsB[2], rxB[2];
#define F_LD(S, kt_) do { tile_ld(rc##S, DC + (kt_) * 64, T, tid); tile_ld(rs##S, DS + (kt_) * 64, T, tid); \
        rx##S[0] = __builtin_nontemporal_load((const bf16x8*)(XZ + (size_t)(kt_) * 64 * NZ + xg0)); rx##S[1] = __builtin_nontemporal_load((const bf16x8*)(XZ + (size_t)((kt_) * 64 + 32) * NZ + xg0)); } while (0)
#define F_ST(S, buf_) do { LAS unsigned char* nb_ = lds + (buf_) * 55296; tile_st((LAS bf16_t*)nb_, rc##S, tid); tile_st((LAS bf16_t*)(nb_ + 18432), rs##S, tid); *(LAS bf16x8*)(nb_ + 36864 + xs0) = rx##S[0]; *(LAS bf16x8*)(nb_ + 36864 + xs1) = rx##S[1]; } while (0)
#define F_MMA(buf_) do { LAS unsigned char* cur = lds + (buf_) * 55296; \
        const LAS bf16_t* lc = (const LAS bf16_t*)cur + (32 * wr + r) * 72 + 8 * hl; const LAS bf16_t* ls = lc + 9216; \
        const int xb_ = (int)(unsigned)(size_t)(cur + 36864) + xrd; \
        _Pragma("unroll") for (int ks = 0; ks < 4; ++ks) { \
            const bf16x8 fc = *(const LAS bf16x8*)(lc + 16 * ks), fs = *(const LAS bf16x8*)(ls + 16 * ks); \
            bf16x8 x0, x1; trfrag2(x0, x1, xb_ + ks * 4096, xb_ + 512 + ks * 4096); \
            __builtin_amdgcn_s_setprio(1); aP[0] = MFMA32(fc, x0, aP[0]); aP[1] = MFMA32(fc, x1, aP[1]); aQ[0] = MFMA32(fs, x0, aQ[0]); aQ[1] = MFMA32(fs, x1, aQ[1]); __builtin_amdgcn_s_setprio(0); } } while (0)
    const int xrd = att::v_rd_base(lane) + wc * 1024;
    F_LD(B, 0); F_ST(B, 0); F_LD(A, 1); __syncthreads();
#pragma unroll 1
    for (int kt = 0; kt < NKT; kt += 2) {
        if (kt + 2 < NKT) F_LD(B, kt + 2);
        F_MMA(0);
        F_ST(A, 1);
        __syncthreads();
        if (kt + 3 < NKT) F_LD(A, kt + 3);
        F_MMA(1);
        if (kt + 2 < NKT) F_ST(B, 0);
        __syncthreads();
    }
#undef F_LD
#undef F_ST
#undef F_MMA
    LAS bf16_t* PQ = (LAS bf16_t*)lds;
#pragma unroll
    for (int cb = 0; cb < 2; ++cb)
#pragma unroll
        for (int i = 0; i < 16; ++i) { const int row = 32 * wr + crow(i, hl);
            PQ[row * 264 + 64 * wc + 32 * cb + r] = f2bf(aP[cb][i]); PQ[row * 264 + 128 + 64 * wc + 32 * cb + r] = f2bf(aQ[cb][i]); }
    LAS bf16_t* CSl = (LAS bf16_t*)(lds + 67584);
#pragma unroll
    for (int i = 0; i < 8; ++i) { const int ch = tid + 512 * i; *(LAS bf16x8*)(CSl + (ch >> 5) * 264 + (ch & 31) * 8) = csr[i]; }
    __syncthreads();
    f32x16 o[2];
#pragma unroll
    for (int i = 0; i < 16; ++i) { o[0][i] = 0.f; o[1][i] = 0.f; }
#pragma unroll
    for (int ks = 0; ks < 16; ++ks) { const bf16x8 af = *(const LAS bf16x8*)(PQ + (32 * wr + r) * 264 + 16 * ks + 8 * hl);
#pragma unroll
        for (int db = 0; db < 2; ++db) { const bf16x8 bfr = *(const LAS bf16x8*)(CSl + (64 * wc + 32 * db + r) * 264 + 16 * ks + 8 * hl); o[db] = MFMA32(af, bfr, o[db]); } }
    const bf16_t* Z = (const bf16_t*)(ws + WS_Z); bf16_t* mix = (bf16_t*)(ws + WS_H);
    const int tokb = (LAT ? 4096 + b * 1024 : b * 256) + tile * 128 + 32 * wr;
#pragma unroll
    for (int i = 0; i < 16; ++i) { const int tok = tokb + crow(i, hl);
#pragma unroll
        for (int db = 0; db < 2; ++db) { const int d = 64 * wc + 32 * db + r; const float fg = bf2f(Z[(size_t)tok * NZ + ZFG + g * 128 + d]);
            mix[(size_t)tok * 2048 + 1536 + g * 128 + d] = f2bf(o[db][i] * silu_f(fg)); } }
    __syncthreads();
}

DI void attn_task(const P& p, unsigned char* lds_generic, int layer, bool LAT, int b, int h, int qb) {
    unsigned char* ws = p.ws;
    const int kvh = h >> 2;
    const int tok0 = LAT ? 4096 + b * 1024 : b * 256, tok = tok0 + qb * 256;
    const bf16_t* Z = (const bf16_t*)(ws + WS_Z);
    const bf16_t* Q = Z + (size_t)tok * NZ + ZQ + h * 128;
    const size_t koff = LAT ? (size_t)KC_ELEMS + (size_t)layer * KL_ELEMS + (size_t)(b * 2 + kvh) * 1536 * 128 : (size_t)(b * 2 + kvh) * 256 * 128;
    const bf16_t* K = (const bf16_t*)(ws + WS_K) + koff; const bf16_t* Vc = (const bf16_t*)(ws + WS_V) + koff;
    const bf16_t* Vz = Z + (size_t)tok0 * NZ + ZV + kvh * 128;
    bf16_t* mix = (bf16_t*)(ws + WS_H) + (size_t)tok * 2048 + h * 128;
    const bf16_t* ag = Z + (size_t)tok * NZ + ZAG + h * 128;
    att::attn_dense_body(Q, K, Vc, Vz, LAT ? 512 : 0, p.in[I_QN] + layer * 128, (const float*)(ws + WS_ROPE), qb * 256, LAT, mix, ag, LAT ? 1536 : 256, (char*)lds_generic);
    __syncthreads();
}

DI void phaseC(const P& p, LAS unsigned char* lds, unsigned char* lds_generic, int layer, int ctr_idx, int types) {
    TID_SETUP
    unsigned* ctr = (unsigned*)(p.ws + WS_CTL) + ctr_idx;
    LAS unsigned* slot = (LAS unsigned*)(lds + LDS_MISC);
    for (;;) {
        if (tid == 0) *slot = atomicAdd(ctr, 1u);
        __syncthreads();
        const int id = __builtin_amdgcn_readfirstlane((int)*slot);
        __syncthreads();
        if (id >= 640) break;
        { const int ty = id < 128 ? 1 : id < 256 ? 4 : id < 384 ? 2 : id < 512 ? 8 : 16; if (!(types & ty)) continue; }
        if (id < 128 || id >= 512) { const bool la = id < 128; const int u = la ? id : id - 512; attn_task(p, lds_generic, layer, la, la ? u >> 5 : u >> 3, la ? (u >> 2) & 7 : u & 7, la ? u & 3 : 0); }
        else if (id >= 256 && id < 384) { m1_group(p, lds, layer, id - 256); }
        else if (id < 256) { const int u = id - 128; fourier_task<true>(p, lds, layer, u >> 5, (u >> 3) & 3, u & 7); }
        else if (id < 512) { const int u = id - 384; fourier_task<false>(p, lds, layer, u >> 3, (u >> 1) & 3, u & 1); }
    }
}

__global__ void __launch_bounds__(512, 2) mega_fwd(P p) {
    extern __shared__ __attribute__((aligned(16))) unsigned char lds_raw[];
    LAS unsigned char* lds = (LAS unsigned char*)lds_raw;
    cg::grid_group grid = cg::this_grid();
    if (threadIdx.x < 4) ((LAS unsigned*)(lds + LDS_MISC))[4 + threadIdx.x] = 0u;
    __syncthreads();
    XcdBarrier xbar = xcd_barrier_post((unsigned*)(p.ws + WS_BAR), (volatile LAS unsigned*)(lds + LDS_MISC) + 4);
    (void)xbar;
#define GSYNC() do { XcdBarrier xb_; xb_.bar = (unsigned*)(p.ws + WS_BAR); xb_.x = xb_xcc_id(); xb_.st = (volatile LAS unsigned*)(lds + LDS_MISC) + 4; xcd_barrier(xb_); } while (0)
    unsigned char* ws = p.ws;
#ifndef DUPMASK
#define DUPMASK 0
#endif
#ifndef DUPC_TYPES
#define DUPC_TYPES 31
#endif
    phase0(p, lds, 0);
    if (p.ws == nullptr) grid.sync();
    GSYNC();
    if (DUPMASK & 1) { phase0(p, lds, 512); GSYNC(); }
    if (DUPMASK & 128) { for (int q = 0; q < 10; ++q) GSYNC(); }
#pragma unroll 1
    for (int layer = 0; layer < 2; ++layer) {
#pragma unroll 1
        for (int rp = 0; rp < ((DUPMASK & 2) ? 2 : 1); ++rp) { phaseA(p, lds, layer); GSYNC(); }
#pragma unroll 1
        for (int rp = 0; rp < ((DUPMASK & 4) ? 2 : 1); ++rp) {
            pg8::Gemm g{(const pg8::bf16_t*)(ws + WS_H), (const pg8::bf16_t*)(ws + WS_WINT) + (size_t)layer * 6144 * 2048, NTOK, NZ, DM};
            pg8::StaticOrder S; S.init(NTOK, NZ, (int)gridDim.x, (int)blockIdx.x);
            pg8::EpiZ E{(pg8::bf16_t*)(ws + WS_Z), NZ, p.out + O_NV + (size_t)layer * 65536};
            pg8::gemm_phase<pg8::EpiZ, pg8::StaticOrder, true, true>(lds, g, S, E);
            GSYNC(); }
#pragma unroll 1
        for (int rp = 0; rp < ((DUPMASK & 8) ? 2 : 1); ++rp) { phaseB2(p, lds, layer); gate_scan_phase(p, lds, layer); GSYNC(); }
#pragma unroll 1
        for (int rp = 0; rp < ((DUPMASK & 16) ? 2 : 1); ++rp) { phaseC(p, lds, lds_raw, layer, 64 * (1 + layer + 2 * rp), rp ? DUPC_TYPES : 31); GSYNC(); }
#pragma unroll 1
        for (int rp = 0; rp < ((DUPMASK & 32) ? 2 : 1); ++rp) {
            for (int slot = blockIdx.x; slot < 256; slot += gridDim.x) m2_block(p, layer, slot);
            GSYNC();
            for (int s = blockIdx.x; s < 512; s += gridDim.x) m3_task(p, lds, layer, s);
            GSYNC(); }
#pragma unroll 1
        for (int rp = 0; rp < ((DUPMASK & 64) ? 2 : 1); ++rp) {
            pg8::Gemm g{(const pg8::bf16_t*)(ws + WS_H), (const pg8::bf16_t*)(ws + WS_WOUTT) + (size_t)layer * 2048 * 2048, NTOK, DM, DM};
            pg8::StaticOrder S; S.init(NTOK, DM, (int)gridDim.x, (int)blockIdx.x);
            const float* modl = (const float*)(ws + WS_MOD) + (size_t)layer * 5 * 6144;
            if (layer == 0) { pg8::EpiRes<false> E{p.in[I_XP], p.in[I_XS], nullptr, (pg8::bf16_t*)(ws + WS_X1B), nullptr, modl}; pg8::gemm_phase<pg8::EpiRes<false>, pg8::StaticOrder, true, true>(lds, g, S, E); }
            else { pg8::EpiRes<true> E{nullptr, nullptr, (const pg8::bf16_t*)(ws + WS_X1B), nullptr, p.out, modl}; pg8::gemm_phase<pg8::EpiRes<true>, pg8::StaticOrder, true, true>(lds, g, S, E); }
            if (layer == 0 || rp + 1 < ((DUPMASK & 64) ? 2 : 1)) GSYNC(); }
    }
}

extern "C" void kernel_launch(void* const* d_in, const int* in_sizes, int n_in, void* d_out, int out_size, void* d_ws, size_t ws_size, hipStream_t stream) {
    static int grid = 0;
    if (grid == 0) {
        if (n_in != 21 || (size_t)out_size != O_END || ws_size < WS_END) { fprintf(stderr, "kernel_launch: unexpected shapes: n_in %d out %d ws %zu (need %zu)\n", n_in, out_size, ws_size, (size_t)WS_END); grid = -1; return; }
        int dev = 0, cus = 0, per_cu = 0;
        hipGetDevice(&dev); hipDeviceGetAttribute(&cus, hipDeviceAttributeMultiprocessorCount, dev);
        if (hipFuncSetAttribute((const void*)mega_fwd, hipFuncAttributeMaxDynamicSharedMemorySize, LDS_BYTES) != hipSuccess) { fprintf(stderr, "kernel_launch: hipFuncSetAttribute failed\n"); grid = -1; return; }
        hipOccupancyMaxActiveBlocksPerMultiprocessor(&per_cu, (const void*)mega_fwd, 512, LDS_BYTES);
        if (per_cu < 1) { fprintf(stderr, "kernel_launch: occupancy query says %d blocks per CU\n", per_cu); per_cu = 1; }
        (void)hipGetLastError();
        grid = cus;
    }
    if (grid < 0) return;
    hipMemsetAsync((char*)d_ws + WS_CTL, 0, 32768, stream);
    P p{};
    for (int i = 0; i < 21; ++i) p.in[i] = (const float*)d_in[i];
    p.out = (float*)d_out; p.ws = (unsigned char*)d_ws;
    void* args[] = {&p};
    hipError_t e = hipLaunchCooperativeKernel((const void*)mega_fwd, dim3(grid), dim3(512), args, LDS_BYTES, stream);
    if (e != hipSuccess) fprintf(stderr, "kernel_launch: cooperative launch failed: %s (grid %d)\n", hipGetErrorString(e), grid);
}
```
